# Optimizing an MI355X kernel written in HIP

```python
import math
import jax, jax.numpy as jnp
from jax import lax
import numpy as np

D_MODEL = 2048
BATCH = 2
SEQ = 8192
DEPTH = 1

D_MIX = D_MODEL
D_A = D_MIX // 2
D_B = D_MIX - D_A
N_HEADS_A = 8
HD_A = D_A // N_HEADS_A
N_GROUPS_B = 8
CHUNK = 128
CONV_W = 3
EMB_DIM = 33
N_BANDS = (EMB_DIM - 1) // 2
FILTER_ORDER = 64
DECAY_TARGET = 1e-2
FAST_DECAY_PCT = 0.3
SLOW_DECAY_PCT = 1.5
D_FF = 5504
D_IN = 2 * D_A + 3 * D_B
EPS = 1e-6

kernel_name = "hybrid_sgu_hyena_convglu_encoder"


def rms_norm(x, g):
    xf = x.astype(jnp.float32)
    y = xf * lax.rsqrt(jnp.mean(xf * xf, axis=-1, keepdims=True) + EPS)
    return (y * g.astype(jnp.float32)).astype(x.dtype)


def dwconv3(x, w, b):
    xp = jnp.pad(x, ((0, 0), (1, 1), (0, 0)))
    return xp[:, :-2] * w[0] + xp[:, 1:-1] * w[1] + xp[:, 2:] * w[2] + b


def positional_features(L):
    t = jnp.linspace(0.0, 1.0, L, dtype=jnp.float32)[:, None]
    w = (2.0 * math.pi / L) * jnp.arange(L, dtype=jnp.float32)[:, None]
    f = jnp.linspace(1e-4, N_BANDS - 1, N_BANDS, dtype=jnp.float32)[None]
    z = jnp.concatenate([t, jnp.cos(f * w), -jnp.sin(f * w)], axis=-1)
    return z, t


def hyena_filter(L, w1, b1, w2, b2, w3, b3, freq, wout):
    f32 = jnp.float32
    z, t = positional_features(L)
    fr = freq.astype(f32)
    h = jnp.sin(fr * (z @ w1.astype(f32) + b1.astype(f32)))
    h = jnp.sin(fr * (h @ w2.astype(f32) + b2.astype(f32)))
    h = jnp.sin(fr * (h @ w3.astype(f32) + b3.astype(f32)))
    h = h @ wout.astype(f32)
    max_decay = math.log(DECAY_TARGET) / FAST_DECAY_PCT
    min_decay = math.log(DECAY_TARGET) / SLOW_DECAY_PCT
    deltas = jnp.abs(jnp.linspace(min_decay, max_decay, D_B, dtype=f32))
    window = jnp.exp(-t * jnp.concatenate([deltas, deltas])[None])
    h = h * window
    h_fwd, h_bwd = h[:, :D_B], h[:, D_B:]
    k = jnp.concatenate([h_fwd, jnp.zeros((1, D_B), f32), h_bwd[:0:-1]], axis=0)
    l1 = jnp.sum(jnp.abs(k), axis=0, keepdims=True)
    return k / (l1 + EPS)


def bidir_long_conv(v, k):
    L = v.shape[1]
    V = jnp.fft.rfft(v.astype(jnp.float32), n=2 * L, axis=1)
    K = jnp.fft.rfft(k, n=2 * L, axis=0)
    return jnp.fft.irfft(V * K[None], n=2 * L, axis=1)[:, :L]


def setup_inputs(seed: int = 0) -> dict:
    key = jax.random.key(seed)
    ks = jax.random.split(key, 32)

    def nrm(k, shape, scale):
        return jax.random.normal(k, shape, jnp.float32) * scale

    def gain(k, shape):
        return 1.0 + 0.02 * jax.random.normal(k, shape, jnp.float32)

    Dp = DEPTH
    return {
        "x": nrm(ks[0], (BATCH, SEQ, D_MODEL), 1.0),
        "norm1_g": gain(ks[1], (Dp, D_MODEL)),
        "w_in": nrm(ks[2], (Dp, D_MODEL, D_IN), D_MODEL ** -0.5),
        "sgu_norm_g": gain(ks[3], (Dp, D_A)),
        "sgu_w": nrm(ks[4], (Dp, N_HEADS_A, CHUNK, CHUNK), CHUNK ** -0.5),
        "sgu_b": gain(ks[5], (Dp, N_HEADS_A, CHUNK)),
        "hy_conv_w": nrm(ks[6], (Dp, CONV_W, 3 * D_B), CONV_W ** -0.5),
        "hy_conv_b": nrm(ks[7], (Dp, 3 * D_B), 0.02),
        "hy_f_w1": nrm(ks[8], (Dp, EMB_DIM, FILTER_ORDER), EMB_DIM ** -0.5),
        "hy_f_b1": nrm(ks[9], (Dp, FILTER_ORDER), 0.1),
        "hy_f_w2": nrm(ks[10], (Dp, FILTER_ORDER, FILTER_ORDER), FILTER_ORDER ** -0.5),
        "hy_f_b2": nrm(ks[11], (Dp, FILTER_ORDER), 0.1),
        "hy_f_w3": nrm(ks[12], (Dp, FILTER_ORDER, FILTER_ORDER), FILTER_ORDER ** -0.5),
        "hy_f_b3": nrm(ks[13], (Dp, FILTER_ORDER), 0.1),
        "hy_f_freq": gain(ks[14], (Dp, FILTER_ORDER)),
        "hy_f_wout": nrm(ks[15], (Dp, FILTER_ORDER, 2 * D_B), FILTER_ORDER ** -0.5),
        "hy_d_skip": nrm(ks[16], (Dp, D_B), 1.0),
        "outnorm_a_g": gain(ks[17], (Dp, D_A)),
        "outnorm_b_g": gain(ks[18], (Dp, D_B)),
        "w_out": nrm(ks[19], (Dp, D_MIX, D_MODEL), D_MIX ** -0.5),
        "norm2_g": gain(ks[20], (Dp, D_MODEL)),
        "ffn_w_up": nrm(ks[21], (Dp, D_MODEL, 2 * D_FF), D_MODEL ** -0.5),
        "ffn_dw_w": nrm(ks[22], (Dp, CONV_W, D_FF), CONV_W ** -0.5),
        "ffn_dw_b": nrm(ks[23], (Dp, D_FF), 0.02),
        "ffn_w_down": nrm(ks[24], (Dp, D_FF, D_MODEL), D_FF ** -0.5),
        "final_g": gain(ks[25], (D_MODEL,)),
    }


def reference(x, norm1_g, w_in, sgu_norm_g, sgu_w, sgu_b, hy_conv_w, hy_conv_b,
              hy_f_w1, hy_f_b1, hy_f_w2, hy_f_b2, hy_f_w3, hy_f_b3, hy_f_freq,
              hy_f_wout, hy_d_skip, outnorm_a_g, outnorm_b_g, w_out, norm2_g,
              ffn_w_up, ffn_dw_w, ffn_dw_b, ffn_w_down, final_g):
    B, L, _ = x.shape
    n_chunks = L // CHUNK
    for l in range(DEPTH):
        h = rms_norm(x, norm1_g[l])
        p = h @ w_in[l]
        a_u = p[..., :D_A]
        a_v = p[..., D_A:2 * D_A]
        b_in = p[..., 2 * D_A:]

        zu = jax.nn.gelu(a_u, approximate=False)
        zv = rms_norm(jax.nn.gelu(a_v, approximate=False), sgu_norm_g[l])
        zv = zv.reshape(B, n_chunks, CHUNK, N_HEADS_A, HD_A)
        s = jnp.einsum('hij,bcjhd->bcihd', sgu_w[l], zv)
        s = s + sgu_b[l].T[None, None, :, :, None]
        y_a = zu * s.reshape(B, L, D_A)

        b_c = dwconv3(b_in, hy_conv_w[l], hy_conv_b[l])
        bx0 = b_c[..., :D_B]
        bx1 = b_c[..., D_B:2 * D_B]
        bv = b_c[..., 2 * D_B:]
        k = hyena_filter(L, hy_f_w1[l], hy_f_b1[l], hy_f_w2[l], hy_f_b2[l],
                         hy_f_w3[l], hy_f_b3[l], hy_f_freq[l], hy_f_wout[l])
        u = bv * bx1
        yc = bidir_long_conv(u, k).astype(x.dtype) + u * hy_d_skip[l]
        y_b = bx0 * yc

        merged = jnp.concatenate([rms_norm(y_a, outnorm_a_g[l]),
                                  rms_norm(y_b, outnorm_b_g[l])], axis=-1)
        x = x + merged @ w_out[l]

        h = rms_norm(x, norm2_g[l])
        gv = h @ ffn_w_up[l]
        g = dwconv3(gv[..., :D_FF], ffn_dw_w[l], ffn_dw_b[l])
        val = gv[..., D_FF:]
        x = x + (jax.nn.gelu(g, approximate=False) * val) @ ffn_w_down[l]
    return rms_norm(x, final_g)
```

```cpp
#include <hip/hip_runtime.h>
#include <cstdio>
#include <cstdint>
namespace pg8 {
#define PG8_LAS __attribute__((address_space(3)))
typedef unsigned short bf16_t;
typedef short bf16x8 __attribute__((ext_vector_type(8)));
typedef float f32x4 __attribute__((ext_vector_type(4)));
typedef unsigned u32x4 __attribute__((ext_vector_type(4)));
constexpr int BM = 256, BK = 64, HALF = 128, HTB = HALF * BK * 2  , STAGE_BYTES = 8 * HTB, NXCD = 8, WGM = 8;

__host__ __device__ __forceinline__ int lds_byte(int r, int c) { const int st = (r >> 4) * 2 + (c >> 5), rr = r & 15, cc = c & 31, ob = rr * 64 + cc * 2; return st * 1024 + (ob ^ (((ob >> 9) & 1) << 5)); }
__host__ __device__ __forceinline__ void stage_rc(int b, int& R, int& C) { const int st = b / 1024, sb = b % 1024, swz = sb ^ (((sb >> 9) & 1) << 5); R = (st >> 1) * 16 + swz / 64; C = (st & 1) * 32 + (swz % 64) / 2; }
__host__ __device__ __forceinline__ int perm32(int rho) { const int n = rho >> 4, i = rho & 15; return 8 * (i >> 2) + 4 * n + (i & 3); }

struct Unit { int pm, pn; };
struct Gemm { const bf16_t* A; const bf16_t* Bt; int M, N, K; };

struct StaticOrder {
    int nM, nN, nwg, G, c;
    __host__ __device__ void init(int M, int N, int G_, int c_) { nM = M / BM; nN = N / BM; nwg = nM * nN; G = G_; c = c_; }
    __host__ __device__ bool next(int i, Unit& u) const {
        const long L = (long)i * G + c; if (L >= nwg) return false;
        int wgid = (int)L; { const int q = nwg / NXCD, r = nwg % NXCD, xcd = wgid % NXCD, off = wgid / NXCD; wgid = (xcd < r ? xcd * (q + 1) : r * (q + 1) + (xcd - r) * q) + off; }
        const int nig = WGM * nN, gid = wgid / nig, fm = gid * WGM, gsz = (nM - fm) < WGM ? (nM - fm) : WGM;
        u.pm = fm + ((wgid % nig) % gsz); u.pn = (wgid % nig) / gsz; return true;
    }
    __device__ __forceinline__ void a_ready(const Unit&) const {}
    __device__ __forceinline__ void done(const Unit&) const {}
};

__device__ __forceinline__ unsigned cvt_pk_bf16(float lo, float hi) { unsigned r; asm volatile("v_cvt_pk_bf16_f32 %0, %1, %2" : "=v"(r) : "v"(lo), "v"(hi)); return r; }
typedef float f32x2 __attribute__((ext_vector_type(2)));
__device__ __forceinline__ f32x2 gelu_pk(f32x2 v) {
    const f32x2 av = __builtin_elementwise_abs(v), d = av * 0.2316418882f + 1.0f;
    f32x2 t; t.x = __builtin_amdgcn_rcpf(d.x); t.y = __builtin_amdgcn_rcpf(d.y);
    f32x2 q = t * 0.5307027145f + (-0.7265760135f); q = q * t + 0.7107068705f; q = q * t + (-0.142248368f); q = q * t + 0.127414796f; q = q * t;
    const f32x2 s = (v * v) * (-0.72134752044f);
    f32x2 e; e.x = __builtin_amdgcn_exp2f(s.x); e.y = __builtin_amdgcn_exp2f(s.y);
    const f32x2 m = v * (q * e), r = v - m;
    f32x2 o; o.x = v.x < 0.f ? m.x : r.x; o.y = v.y < 0.f ? m.y : r.y; return o;
}

template <int ACT  > struct EpiBf16 {
    static constexpr bool PERM = true, AFTER_DRAIN = false; static_assert(ACT == 0 || ACT == 1, "EpiBf16: ACT is 0 (none) or 1 (gelu_pk)");
    bf16_t* O; int ldc; const float* bias; int split_cols; size_t split_stride; float scale0;
    __device__ __forceinline__ void operator()(const f32x4 (&acc)[2][2][4][2], const Unit& u, int wr, int wc, int fr, int fq) const {
        const int row0 = u.pm * BM + wr * 64 + fr; int colt = u.pn * BM; bf16_t* base = O;
        float sc = 1.f; if (split_cols) { const int t = colt / split_cols; base += (size_t)t * split_stride; colt -= t * split_cols; if (t == 0) sc = scale0; }
        const int col0 = colt + wc * 32 + 8 * fq, bcol0 = u.pn * BM + wc * 32 + 8 * fq;
        f32x4 bv[2][2];
#pragma unroll
        for (int bj = 0; bj < 2; ++bj)
#pragma unroll
            for (int n = 0; n < 2; ++n) bv[bj][n] = bias ? *(const f32x4*)(bias + bcol0 + bj * HALF + 4 * n) : (f32x4){0.f, 0.f, 0.f, 0.f};
#pragma unroll
        for (int ai = 0; ai < 2; ++ai)
#pragma unroll
            for (int m = 0; m < 4; ++m) { bf16_t* rowp = base + (size_t)(row0 + ai * HALF + m * 16) * ldc + col0;
#pragma unroll
                for (int bj = 0; bj < 2; ++bj) { f32x4 v0 = acc[ai][bj][m][0] + bv[bj][0], v1 = acc[ai][bj][m][1] + bv[bj][1];
                    if (ACT == 1) { f32x2 a = gelu_pk((f32x2){v0[0], v0[1]}), b = gelu_pk((f32x2){v0[2], v0[3]}), c = gelu_pk((f32x2){v1[0], v1[1]}), d = gelu_pk((f32x2){v1[2], v1[3]});
                        v0 = (f32x4){a.x, a.y, b.x, b.y}; v1 = (f32x4){c.x, c.y, d.x, d.y}; }
                    v0 = v0 * sc; v1 = v1 * sc; u32x4 w; w.x = cvt_pk_bf16(v0[0], v0[1]); w.y = cvt_pk_bf16(v0[2], v0[3]); w.z = cvt_pk_bf16(v1[0], v1[1]); w.w = cvt_pk_bf16(v1[2], v1[3]);
                    *(u32x4*)(rowp + bj * HALF) = w; } }
    }
};
template <class Epi, class Sched, bool ALIGN_EPI = false, bool SP2 = false>
__device__ __forceinline__ void gemm_phase(PG8_LAS unsigned char* lds, const Gemm g, const Sched& S, const Epi& E) {
    int tid_ = threadIdx.x; asm volatile("" : "+v"(tid_));
    const int tid = tid_, wid = __builtin_amdgcn_readfirstlane(tid >> 6), lane = tid & 63, wr = wid >> 2, wc = wid & 3, fr = lane & 15, fq = lane >> 4;
    const int K = g.K, nt = K / BK;
    unsigned voffA[2], voffB[2];
#pragma unroll
    for (int i = 0; i < 2; ++i) { int R, C; stage_rc(tid * 16 + i * 8192, R, C); const int Rb = Epi::PERM ? ((R & ~31) + perm32(R & 31)) : R;
        voffA[i] = (unsigned)(R * K + C) * 2u; voffB[i] = (unsigned)(Rb * K + C) * 2u; }
    const size_t kstep = (size_t)(BK * 2);
    const size_t hstep = (size_t)HALF * K * 2;
    const size_t tstep = 2 * hstep;
    const unsigned ldsw = (unsigned)wid * 1024u;
    const int aoff = lds_byte(wr * 64 + fr, fq * 8), boff = lds_byte(wc * 32 + fr, fq * 8);
#define PG8_SA(b, h) (((b) * 2 + (h)) * HTB)
#define PG8_SB(b, h) ((4 + (b) * 2 + (h)) * HTB)
#define PG8_STAGE(bufoff, gbase, voff) do { _Pragma("unroll") for (int _i = 0; _i < 2; ++_i) \
        __builtin_amdgcn_global_load_lds((const unsigned*)((const char*)(gbase) + (voff)[_i]), (PG8_LAS unsigned*)(lds + (bufoff) + ldsw + _i * 8192), 16, 0, 0); } while (0)
#define PG8_LDA(dst, b, h) do { _Pragma("unroll") for (int m = 0; m < 4; ++m) _Pragma("unroll") for (int k = 0; k < 2; ++k) dst[m][k] = *(const PG8_LAS bf16x8*)(lds + PG8_SA(b, h) + aoff + m * 2048 + k * 1024); } while (0)
#define PG8_LDB(dst, b, h) do { _Pragma("unroll") for (int n = 0; n < 2; ++n) _Pragma("unroll") for (int k = 0; k < 2; ++k) dst[n][k] = *(const PG8_LAS bf16x8*)(lds + PG8_SB(b, h) + boff + n * 2048 + k * 1024); } while (0)
#define PG8_MMA(ai, bj, At, Bt) do { __builtin_amdgcn_s_setprio(1); _Pragma("unroll") for (int m = 0; m < 4; ++m) _Pragma("unroll") for (int n = 0; n < 2; ++n) _Pragma("unroll") for (int k = 0; k < 2; ++k) \
        acc[ai][bj][m][n] = __builtin_amdgcn_mfma_f32_16x16x32_bf16(Bt[n][k], At[m][k], acc[ai][bj][m][n], 0, 0, 0); __builtin_amdgcn_s_setprio(0); } while (0)
#define PG8_WAIT_V(n) asm volatile("s_waitcnt vmcnt(" #n ")" ::: "memory")
#define PG8_WAIT_L(n) asm volatile("s_waitcnt lgkmcnt(" #n ")" ::: "memory")
#define PG8_BAR __builtin_amdgcn_s_barrier()
#define PG8_SCHED __builtin_amdgcn_sched_barrier(0)
    Unit cur, nxt; int ui = 0;
    if (!S.next(0, cur)) return;
    f32x4 acc[2][2][4][2];
#pragma unroll
    for (int a = 0; a < 2; ++a)
#pragma unroll
        for (int b = 0; b < 2; ++b)
#pragma unroll
            for (int m = 0; m < 4; ++m)
#pragma unroll
                for (int n = 0; n < 2; ++n) acc[a][b][m][n] = (f32x4){0.f, 0.f, 0.f, 0.f};
    bf16x8 At[4][2], B0[2][2], B1[2][2];
    const char* cA = (const char*)g.A + (size_t)cur.pm * tstep; const char* cB = (const char*)g.Bt + (size_t)cur.pn * tstep;
    S.a_ready(cur);
    if constexpr (SP2) {
        PG8_STAGE(PG8_SB(0, 0), cB, voffB); PG8_STAGE(PG8_SB(0, 1), cB + hstep, voffB); PG8_STAGE(PG8_SA(0, 0), cA, voffA); PG8_STAGE(PG8_SA(0, 1), cA + hstep, voffA);
        if (wr == 1) PG8_BAR;
        PG8_WAIT_V(2); PG8_BAR;
        PG8_STAGE(PG8_SB(1, 0), cB + kstep, voffB); PG8_STAGE(PG8_SA(1, 0), cA + kstep, voffA); PG8_STAGE(PG8_SB(1, 1), cB + hstep + kstep, voffB);
        PG8_WAIT_V(6); PG8_BAR;
    } else {
        PG8_STAGE(PG8_SB(0, 0), cB, voffB); PG8_STAGE(PG8_SA(0, 0), cA, voffA); PG8_STAGE(PG8_SB(0, 1), cB + hstep, voffB); PG8_STAGE(PG8_SA(0, 1), cA + hstep, voffA);
        if (wr == 1) PG8_BAR;
        PG8_WAIT_V(4); PG8_BAR;
        PG8_STAGE(PG8_SB(1, 0), cB + kstep, voffB); PG8_STAGE(PG8_SA(1, 0), cA + kstep, voffA); PG8_STAGE(PG8_SB(1, 1), cB + hstep + kstep, voffB);
        PG8_WAIT_V(6); PG8_BAR;
    }
    for (;;) {
        const bool has_next = S.next(ui + 1, nxt);
        const char* nA = has_next ? (const char*)g.A + (size_t)nxt.pm * tstep : cA; const char* nB = has_next ? (const char*)g.Bt + (size_t)nxt.pn * tstep : cB;
        for (int t = 0; t < nt; t += 2) {
            const bool last = (t == nt - 2);
            const char* a1 = cA + (size_t)(t + 1) * kstep;
            const char* a2 = last ? nA : cA + (size_t)(t + 2) * kstep; const char* b2 = last ? nB : cB + (size_t)(t + 2) * kstep;
            const char* a3 = a2 + kstep; const char* b3 = b2 + kstep;
            if (last && has_next) S.a_ready(nxt);
            if constexpr (SP2) {
            PG8_LDB(B0, 0, 0); PG8_LDB(B1, 0, 1); PG8_SCHED; PG8_LDA(At, 0, 0); PG8_STAGE(PG8_SA(1, 1), a1 + hstep, voffA);
            PG8_WAIT_V(8); PG8_WAIT_L(0); PG8_BAR; PG8_MMA(0, 0, At, B0); PG8_MMA(0, 1, At, B1); PG8_BAR; PG8_SCHED;
            PG8_LDA(At, 0, 1); PG8_STAGE(PG8_SB(0, 0), b2, voffB); PG8_STAGE(PG8_SB(0, 1), b2 + hstep, voffB); PG8_STAGE(PG8_SA(0, 0), a2, voffA);
            PG8_WAIT_V(8); PG8_WAIT_L(0); PG8_BAR; PG8_MMA(1, 0, At, B0); PG8_MMA(1, 1, At, B1); PG8_BAR; PG8_SCHED;
            PG8_LDB(B0, 1, 0); PG8_LDB(B1, 1, 1); PG8_SCHED; PG8_LDA(At, 1, 0); PG8_STAGE(PG8_SA(0, 1), a2 + hstep, voffA);
            PG8_WAIT_V(8); PG8_WAIT_L(0); PG8_BAR; PG8_MMA(0, 0, At, B0); PG8_MMA(0, 1, At, B1); PG8_BAR; PG8_SCHED;
            PG8_LDA(At, 1, 1); PG8_STAGE(PG8_SB(1, 0), b3, voffB); PG8_STAGE(PG8_SB(1, 1), b3 + hstep, voffB); PG8_STAGE(PG8_SA(1, 0), a3, voffA);
            PG8_WAIT_V(8); PG8_WAIT_L(0); PG8_BAR; PG8_MMA(1, 0, At, B0); PG8_MMA(1, 1, At, B1); PG8_BAR; PG8_SCHED;
            } else {
            PG8_LDB(B0, 0, 0); PG8_SCHED; PG8_LDA(At, 0, 0); PG8_STAGE(PG8_SA(1, 1), a1 + hstep, voffA);
            PG8_WAIT_L(8); PG8_BAR; PG8_WAIT_L(0); PG8_MMA(0, 0, At, B0); PG8_BAR; PG8_SCHED;
            PG8_LDB(B1, 0, 1); PG8_STAGE(PG8_SB(0, 0), b2, voffB);
            PG8_BAR; PG8_WAIT_L(0); PG8_MMA(0, 1, At, B1); PG8_BAR;
            PG8_LDA(At, 0, 1); PG8_STAGE(PG8_SA(0, 0), a2, voffA);
            PG8_BAR; PG8_WAIT_L(0); PG8_MMA(1, 0, At, B0); PG8_BAR; PG8_SCHED;
            PG8_STAGE(PG8_SB(0, 1), b2 + hstep, voffB);
            PG8_WAIT_V(6); PG8_BAR; PG8_MMA(1, 1, At, B1); PG8_BAR;
            PG8_LDB(B0, 1, 0); PG8_SCHED; PG8_LDA(At, 1, 0); PG8_STAGE(PG8_SA(0, 1), a2 + hstep, voffA);
            PG8_WAIT_L(8); PG8_BAR; PG8_WAIT_L(0); PG8_MMA(0, 0, At, B0); PG8_BAR; PG8_SCHED;
            PG8_LDB(B1, 1, 1); PG8_STAGE(PG8_SB(1, 0), b3, voffB);
            PG8_BAR; PG8_WAIT_L(0); PG8_MMA(0, 1, At, B1); PG8_BAR;
            PG8_LDA(At, 1, 1); PG8_STAGE(PG8_SA(1, 0), a3, voffA);
            PG8_BAR; PG8_WAIT_L(0); PG8_MMA(1, 0, At, B0); PG8_BAR; PG8_SCHED;
            PG8_STAGE(PG8_SB(1, 1), b3 + hstep, voffB);
            PG8_WAIT_V(6); PG8_BAR; PG8_MMA(1, 1, At, B1); PG8_BAR;
            }
        }
        if constexpr (ALIGN_EPI) { if (wr == 0) PG8_BAR; }
        if constexpr (!Epi::AFTER_DRAIN) { E(acc, cur, wr, wc, fr, fq); S.done(cur); }
        if (!has_next) break;
#pragma unroll
        for (int a = 0; a < 2; ++a)
#pragma unroll
            for (int b = 0; b < 2; ++b)
#pragma unroll
                for (int m = 0; m < 4; ++m)
#pragma unroll
                    for (int n = 0; n < 2; ++n) acc[a][b][m][n] = (f32x4){0.f, 0.f, 0.f, 0.f};
        cur = nxt; cA = nA; cB = nB; ++ui;
        if constexpr (ALIGN_EPI) { if (wr == 1) PG8_BAR; }
    }
    PG8_WAIT_V(0);
    if constexpr (!ALIGN_EPI) { if (wr == 0) PG8_BAR; }
    PG8_BAR;
    if constexpr (Epi::AFTER_DRAIN) { E.fused(acc, cur, wr, wc, fr, fq, lds, wid, lane); S.done(cur); }
#undef PG8_SA
#undef PG8_SB
#undef PG8_STAGE
#undef PG8_LDA
#undef PG8_LDB
#undef PG8_MMA
#undef PG8_WAIT_V
#undef PG8_WAIT_L
#undef PG8_BAR
#undef PG8_SCHED
}
}

#ifndef PG8_SP2
#define PG8_SP2 true
#endif
#ifndef PG8_ALIGN
#define PG8_ALIGN true
#endif

constexpr int NWAVES = 8;
constexpr int BATCH = 2, SEQ = 8192, DM = 2048, M = BATCH * SEQ;
constexpr int DA = 1024, DB = 1024, NHA = 8, DIN = 5120, DFF = 5504, NUP = 2 * DFF;
constexpr float EPS = 1e-6f;
constexpr int FORD = 64;

constexpr size_t MiB = 1u << 20;
constexpr size_t WS_CTL = 0, CTL_ZERO_BYTES = 65536;
constexpr size_t WS_SS = 1 * MiB;
constexpr size_t WS_WIN = 2 * MiB, WS_WOUT = 22 * MiB, WS_WUP = 30 * MiB, WS_WDN = 73 * MiB;
constexpr size_t WS_XN1 = 96 * MiB, WS_ZU = 160 * MiB, WS_ZVT = 192 * MiB, WS_BINT = 224 * MiB;
constexpr size_t WS_H3 = 320 * MiB, WS_HT = 322 * MiB, WS_YBT = 386 * MiB, WS_MRG = 418 * MiB;
constexpr size_t WS_H = 96 * MiB;
constexpr size_t WS_XB2 = 269 * MiB;
constexpr size_t WS_GVH = 336 * MiB;
constexpr size_t WS_END = 508 * MiB;
constexpr int CW_TMO = 0, CW_CODE = 1, CW_BAR = 4096;

constexpr int RING_OFF = 0, RING_BYTES = 131072;
constexpr int LDS_BYTES = 163840;
constexpr int LDSCTL_OFF = LDS_BYTES - 1024, MISC_OFF = LDSCTL_OFF + 320;
constexpr int RED_OFF = MISC_OFF + 128;
static_assert(RED_OFF + 256 <= LDS_BYTES, "LDS map");

#define GAS __attribute__((address_space(1)))
#define LAS __attribute__((address_space(3)))
typedef unsigned short bf16;
typedef unsigned v4u __attribute__((ext_vector_type(4)));
typedef float f32x4 __attribute__((ext_vector_type(4)));
typedef short bf16x8 __attribute__((ext_vector_type(8)));
typedef GAS unsigned gu32;
typedef GAS unsigned long long gu64;
#define RLX_AGENT __ATOMIC_RELAXED, __HIP_MEMORY_SCOPE_AGENT
#define LDS_WAIT() asm volatile("s_waitcnt lgkmcnt(0)" ::: "memory")
#define VM_WAIT() asm volatile("s_waitcnt vmcnt(0)" ::: "memory")
__device__ __forceinline__ unsigned long long rt() { return __builtin_amdgcn_s_memrealtime(); }
__device__ __forceinline__ unsigned f2bf(float f) { unsigned u = __builtin_bit_cast(unsigned, f); return (u + 0x7fffu + ((u >> 16) & 1u)) >> 16; }
__device__ __forceinline__ unsigned pk2(float lo, float hi) { return f2bf(lo) | (f2bf(hi) << 16); }

#define XB_TMO      128
#define XB_XCNT(j)  (256  + 64 * (j))
#define XB_XSUB(j)  (1280 + 64 * (j))
#define XB_XGEN(j)  (2304 + 64 * (j))
#define XB_TOP      3328
#define XB_TOPGEN   3392
#define XCD_BAR_WORDS 3456
#define XB_SPIN_CAP (1u << 18)

__device__ __forceinline__ unsigned xb_ld(unsigned* p)              { return __hip_atomic_load(p, __ATOMIC_RELAXED, __HIP_MEMORY_SCOPE_AGENT); }
__device__ __forceinline__ unsigned xb_add(unsigned* p, unsigned v) { return __hip_atomic_fetch_add(p, v, __ATOMIC_RELAXED, __HIP_MEMORY_SCOPE_AGENT); }
__device__ __forceinline__ unsigned xb_xcc_id() { return (unsigned)__builtin_amdgcn_s_getreg((3 << 11) | 20) & 0xFu; }
#define XB_SPIN(cond, bar) do { unsigned _sp = 0; while (cond) { __builtin_amdgcn_s_sleep(1); \
    if ((++_sp & 255u) == 0u) { if (xb_ld(&(bar)[XB_TMO])) break; if (_sp > XB_SPIN_CAP) { atomicAdd(&(bar)[XB_TMO], 1u); break; } } } } while (0)

struct XcdBarrier {
    unsigned* bar; unsigned x;
    volatile LAS unsigned* st;
};

__device__ __forceinline__ XcdBarrier xcd_barrier_post(unsigned* bar, volatile LAS unsigned* st) {
    XcdBarrier b; b.bar = bar; b.x = xb_xcc_id(); b.st = st;
    if (threadIdx.x == 0) (void)xb_add(&bar[XB_XCNT(b.x)], 1u);
    return b;
}
__device__ __forceinline__ void xcd_barrier_complete(unsigned* bar, unsigned x, unsigned& nloc, unsigned& nx) {
    const unsigned G = gridDim.x * gridDim.y * gridDim.z;
    unsigned sum, cnt, mine, sp = 0u;
    for (;;) {
        sum = 0u; cnt = 0u; mine = 0u;
#pragma unroll
        for (unsigned j = 0; j < 16; ++j) { const unsigned c = xb_ld(&bar[XB_XCNT(j)]); sum += c; cnt += (c > 0u) ? 1u : 0u; mine = (j == x) ? c : mine; }
        if (sum == G) break;
        __builtin_amdgcn_s_sleep(1);
        if ((++sp & 255u) == 0u) { if (xb_ld(&bar[XB_TMO])) break; if (sp > XB_SPIN_CAP) { atomicAdd(&bar[XB_TMO], 1u); break; } }
    }
    nloc = mine > 0u ? mine : 1u; nx = cnt > 0u ? cnt : 1u;
}

__device__ __forceinline__ void xcd_barrier(const XcdBarrier& b) {
    asm volatile("s_waitcnt vmcnt(0)" ::: "memory");
    __syncthreads();
    if (threadIdx.x == 0) {
        unsigned* bar = b.bar;
        __builtin_amdgcn_s_waitcnt(0);
        unsigned nloc = b.st[0], nx = b.st[1];
        if (nloc == 0u) { xcd_barrier_complete(bar, b.x, nloc, nx); b.st[0] = nloc; b.st[1] = nx; }
        const unsigned old = xb_add(&bar[XB_XSUB(b.x)], 1u);
        const unsigned gen = old / nloc;
        if (old + 1u == (gen + 1u) * nloc) {
            __builtin_amdgcn_fence(__ATOMIC_RELEASE, "agent");
            asm volatile("s_waitcnt vmcnt(0)" ::: "memory");
            const unsigned og = xb_add(&bar[XB_TOP], 1u);
            const unsigned tg = og / nx;
            if (og + 1u == (tg + 1u) * nx) xb_add(&bar[XB_TOPGEN], 1u);
            else XB_SPIN(xb_ld(&bar[XB_TOPGEN]) == tg, bar);
            __builtin_amdgcn_fence(__ATOMIC_ACQUIRE, "agent");
            xb_add(&bar[XB_XGEN(b.x)], 1u);
            asm volatile("s_waitcnt vmcnt(0)" ::: "memory");
        } else {
            XB_SPIN(xb_ld(&bar[XB_XGEN(b.x)]) == gen, bar);
            __builtin_amdgcn_fence(__ATOMIC_ACQUIRE, "agent");
            asm volatile("s_waitcnt vmcnt(0)" ::: "memory");
        }
    }
    __syncthreads();
}

typedef unsigned u32x2 __attribute__((ext_vector_type(2)));
struct Frame {
    LAS unsigned char* lds;
    volatile LAS unsigned* MISC;
    gu32* ctl;
    int tid, lane, wave;
    int vcu, G;
    const float *x, *norm1_g, *w_in, *sgu_norm_g, *sgu_w, *sgu_b, *hy_conv_w, *hy_conv_b;
    const float *f_w1, *f_b1, *f_w2, *f_b2, *f_w3, *f_b3, *f_freq, *f_wout, *d_skip;
    const float *on_a_g, *on_b_g, *w_out, *norm2_g, *w_up, *dw_w, *dw_b, *w_down, *final_g;
    float* out;
    float *ssv, *ssa, *ss2, *ss3, *h3, *hT;
    bf16 *Wt_in, *Wt_out, *Wt_up, *Wt_dn, *xn1, *zu, *zvT, *binT, *ybT, *mrg, *hb, *xb2, *gvh;
};
struct Args { const float* in[26]; float* out; unsigned char* ws; int ph_lo, ph_hi, li, pad; };
__device__ __forceinline__ const Args* kargs() {
    const Args* p = (const Args*)__builtin_amdgcn_kernarg_segment_ptr();
    asm volatile("" : "+s"(p));
    return p;
}
__device__ __forceinline__ void frame_ptrs(Frame& F) {
    const Args* A = kargs();
    unsigned char* ws = A->ws;
    F.ctl = (gu32*)(ws + WS_CTL);
    F.x = A->in[0]; F.norm1_g = A->in[1]; F.w_in = A->in[2]; F.sgu_norm_g = A->in[3]; F.sgu_w = A->in[4]; F.sgu_b = A->in[5];
    F.hy_conv_w = A->in[6]; F.hy_conv_b = A->in[7]; F.f_w1 = A->in[8]; F.f_b1 = A->in[9]; F.f_w2 = A->in[10]; F.f_b2 = A->in[11];
    F.f_w3 = A->in[12]; F.f_b3 = A->in[13]; F.f_freq = A->in[14]; F.f_wout = A->in[15]; F.d_skip = A->in[16];
    F.on_a_g = A->in[17]; F.on_b_g = A->in[18]; F.w_out = A->in[19]; F.norm2_g = A->in[20]; F.w_up = A->in[21];
    F.dw_w = A->in[22]; F.dw_b = A->in[23]; F.w_down = A->in[24]; F.final_g = A->in[25]; F.out = A->out;
    F.ssv = (float*)(ws + WS_SS); F.ssa = F.ssv + M; F.ss2 = F.ssa + M; F.ss3 = F.ss2 + M;
    F.h3 = (float*)(ws + WS_H3); F.hT = (float*)(ws + WS_HT);
    F.Wt_in = (bf16*)(ws + WS_WIN); F.Wt_out = (bf16*)(ws + WS_WOUT); F.Wt_up = (bf16*)(ws + WS_WUP); F.Wt_dn = (bf16*)(ws + WS_WDN);
    F.xn1 = (bf16*)(ws + WS_XN1); F.zu = (bf16*)(ws + WS_ZU); F.zvT = (bf16*)(ws + WS_ZVT); F.binT = (bf16*)(ws + WS_BINT);
    F.ybT = (bf16*)(ws + WS_YBT); F.mrg = (bf16*)(ws + WS_MRG); F.hb = (bf16*)(ws + WS_H); F.xb2 = (bf16*)(ws + WS_XB2); F.gvh = (bf16*)(ws + WS_GVH);
}


__device__ __forceinline__ float wave_sum(float v) {
#pragma unroll
    for (int o = 1; o < 64; o <<= 1) v += __shfl_xor(v, o);
    return v;
}
__device__ __forceinline__ float bf2f(unsigned short b) { return __builtin_bit_cast(float, ((unsigned)b) << 16); }
__device__ __forceinline__ float bflo(unsigned w) { return __builtin_bit_cast(float, w << 16); }
__device__ __forceinline__ float bfhi(unsigned w) { return __builtin_bit_cast(float, w & 0xffff0000u); }
__device__ __forceinline__ float gelu_f(float v) { return 0.5f * v * (1.0f + erff(v * 0.70710678118654752f)); }
__device__ __forceinline__ float rsq(float v) { return 1.0f / sqrtf(v); }

namespace pg8 {
struct Epi1b {
    static constexpr bool PERM = true, AFTER_DRAIN = false;
    bf16_t* zvT; bf16_t* binT; const float* g_sgu; float* ssv;
    __device__ __forceinline__ void operator()(const f32x4 (&acc)[2][2][4][2], const Unit& u, int wr, int wc, int fr, int fq) const {
        const int row0 = u.pm * BM + wr * 64 + fr, col0 = u.pn * BM + wc * 32 + 8 * fq;
        if (u.pm < 4) {
            float ss[2][8];
#pragma unroll
            for (int bj = 0; bj < 2; ++bj)
#pragma unroll
                for (int k = 0; k < 8; ++k) ss[bj][k] = 0.f;
#pragma unroll
            for (int ai = 0; ai < 2; ++ai)
#pragma unroll
                for (int m = 0; m < 4; ++m) { const int r = row0 + ai * HALF + m * 16; const float gg = g_sgu[r]; bf16_t* rowp = zvT + (size_t)r * 16384 + col0;
#pragma unroll
                    for (int bj = 0; bj < 2; ++bj) { const f32x4 v0 = acc[ai][bj][m][0], v1 = acc[ai][bj][m][1];
                        const f32x2 a = gelu_pk((f32x2){v0[0], v0[1]}), b = gelu_pk((f32x2){v0[2], v0[3]}), c = gelu_pk((f32x2){v1[0], v1[1]}), d = gelu_pk((f32x2){v1[2], v1[3]});
                        ss[bj][0] += a.x * a.x; ss[bj][1] += a.y * a.y; ss[bj][2] += b.x * b.x; ss[bj][3] += b.y * b.y;
                        ss[bj][4] += c.x * c.x; ss[bj][5] += c.y * c.y; ss[bj][6] += d.x * d.x; ss[bj][7] += d.y * d.y;
                        u32x4 w; w.x = cvt_pk_bf16(a.x * gg, a.y * gg); w.y = cvt_pk_bf16(b.x * gg, b.y * gg); w.z = cvt_pk_bf16(c.x * gg, c.y * gg); w.w = cvt_pk_bf16(d.x * gg, d.y * gg);
                        *(u32x4*)(rowp + bj * HALF) = w; } }
#pragma unroll
            for (int bj = 0; bj < 2; ++bj)
#pragma unroll
                for (int k = 0; k < 8; ++k) { float v = ss[bj][k]; v += __shfl_xor(v, 1); v += __shfl_xor(v, 2); v += __shfl_xor(v, 4); v += __shfl_xor(v, 8);
                    if (fr == 0) atomicAdd(ssv + col0 + bj * HALF + k, v); }
        } else {
#pragma unroll
            for (int ai = 0; ai < 2; ++ai)
#pragma unroll
                for (int m = 0; m < 4; ++m) { const int r = row0 + ai * HALF + m * 16 - 1024; bf16_t* rowp = binT + (size_t)r * 16384 + col0;
#pragma unroll
                    for (int bj = 0; bj < 2; ++bj) { const f32x4 v0 = acc[ai][bj][m][0], v1 = acc[ai][bj][m][1];
                        u32x4 w; w.x = cvt_pk_bf16(v0[0], v0[1]); w.y = cvt_pk_bf16(v0[2], v0[3]); w.z = cvt_pk_bf16(v1[0], v1[1]); w.w = cvt_pk_bf16(v1[2], v1[3]);
                        *(u32x4*)(rowp + bj * HALF) = w; } }
        }
    }
};
struct Epi2 {
    static constexpr bool PERM = true, AFTER_DRAIN = false;
    const float* x; float* x1; bf16_t* xb2; const float* ssa; float* ss2;
    __device__ __forceinline__ void operator()(const f32x4 (&acc)[2][2][4][2], const Unit& u, int wr, int wc, int fr, int fq) const {
        const int row0 = u.pm * BM + wr * 64 + fr, col0 = u.pn * BM + wc * 32 + 8 * fq;
#pragma unroll
        for (int ai = 0; ai < 2; ++ai)
#pragma unroll
            for (int m = 0; m < 4; ++m) { const int r = row0 + ai * HALF + m * 16; const float ra = 1.0f / sqrtf(ssa[r] * (1.0f / 1024.0f) + 1e-6f); float s = 0.f;
                const size_t off = (size_t)r * 2048 + col0;
#pragma unroll
                for (int bj = 0; bj < 2; ++bj) { const f32x4 x0 = *(const f32x4*)(x + off + bj * HALF), x4 = *(const f32x4*)(x + off + bj * HALF + 4);
                    const f32x4 v0 = x0 + acc[ai][bj][m][0] * ra, v1 = x4 + acc[ai][bj][m][1] * ra;
                    *(f32x4*)(x1 + off + bj * HALF) = v0; *(f32x4*)(x1 + off + bj * HALF + 4) = v1;
                    s += (v0[0] * v0[0] + v0[1] * v0[1]) + (v0[2] * v0[2] + v0[3] * v0[3]) + (v1[0] * v1[0] + v1[1] * v1[1]) + (v1[2] * v1[2] + v1[3] * v1[3]);
                    u32x4 w; w.x = cvt_pk_bf16(v0[0], v0[1]); w.y = cvt_pk_bf16(v0[2], v0[3]); w.z = cvt_pk_bf16(v1[0], v1[1]); w.w = cvt_pk_bf16(v1[2], v1[3]);
                    *(u32x4*)(xb2 + off + bj * HALF) = w; }
                s += __shfl_xor(s, 16); s += __shfl_xor(s, 32);
                if (fq == 0) atomicAdd(ss2 + r, s);
                asm volatile("" ::: "memory"); }
    }
};
struct Epi3raw {
    static constexpr bool PERM = true, AFTER_DRAIN = false;
    bf16_t* gv; const float* ss2; int row_base;
    __device__ __forceinline__ void operator()(const f32x4 (&acc)[2][2][4][2], const Unit& u, int wr, int wc, int fr, int fq) const {
        const int row0 = u.pm * BM + wr * 64 + fr, col0 = u.pn * BM + wc * 32 + 8 * fq;
#pragma unroll
        for (int ai = 0; ai < 2; ++ai)
#pragma unroll
            for (int m = 0; m < 4; ++m) { const int r = row0 + ai * HALF + m * 16; const float r2 = 1.0f / sqrtf(ss2[row_base + r] * (1.0f / 2048.0f) + 1e-6f);
                bf16_t* rowp = gv + (size_t)r * 11008 + col0;
#pragma unroll
                for (int bj = 0; bj < 2; ++bj) { const f32x4 v0 = acc[ai][bj][m][0] * r2, v1 = acc[ai][bj][m][1] * r2;
                    u32x4 w; w.x = cvt_pk_bf16(v0[0], v0[1]); w.y = cvt_pk_bf16(v0[2], v0[3]); w.z = cvt_pk_bf16(v1[0], v1[1]); w.w = cvt_pk_bf16(v1[2], v1[3]);
                    *(u32x4*)(rowp + bj * HALF) = w; } }
    }
};
struct Epi4 {
    static constexpr bool PERM = true, AFTER_DRAIN = false;
    float* x1; float* ss3;
    __device__ __forceinline__ void operator()(const f32x4 (&acc)[2][2][4][2], const Unit& u, int wr, int wc, int fr, int fq) const {
        const int row0 = u.pm * BM + wr * 64 + fr, col0 = u.pn * BM + wc * 32 + 8 * fq;
#pragma unroll
        for (int ai = 0; ai < 2; ++ai)
#pragma unroll
            for (int m = 0; m < 4; ++m) { const int r = row0 + ai * HALF + m * 16; float s = 0.f; const size_t off = (size_t)r * 2048 + col0;
#pragma unroll
                for (int bj = 0; bj < 2; ++bj) { const f32x4 x0 = *(const f32x4*)(x1 + off + bj * HALF), x4 = *(const f32x4*)(x1 + off + bj * HALF + 4);
                    const f32x4 v0 = x0 + acc[ai][bj][m][0], v1 = x4 + acc[ai][bj][m][1];
                    *(f32x4*)(x1 + off + bj * HALF) = v0; *(f32x4*)(x1 + off + bj * HALF + 4) = v1;
                    s += (v0[0] * v0[0] + v0[1] * v0[1]) + (v0[2] * v0[2] + v0[3] * v0[3]) + (v1[0] * v1[0] + v1[1] * v1[1]) + (v1[2] * v1[2] + v1[3] * v1[3]); }
                s += __shfl_xor(s, 16); s += __shfl_xor(s, 32);
                if (fq == 0) atomicAdd(ss3 + r, s);
                asm volatile("" ::: "memory"); }
    }
};
}

template <int MODE  >
__device__ __forceinline__ void p0_transpose_item(const float* W, int K, int N, bf16* WT, const float* kscale, LAS float* scr, int item, int lane) {
    const int nblk = N / 32, kb = item / nblk, nb = item % nblk, k0 = 64 * kb, n0 = 32 * nb;
#pragma unroll 8
    for (int i = 0; i < 32; ++i) { const int kk = 2 * i + (lane >> 5); float v = W[(size_t)(k0 + kk) * N + n0 + (lane & 31)]; if (kscale) v *= kscale[k0 + kk]; scr[kk * 33 + (lane & 31)] = v; }
    LDS_WAIT(); asm volatile("" ::: "memory");
    const int c = lane & 7;
    int r0 = n0;
    if (MODE == 1) { const int half = n0 / DFF, rem = n0 % DFF, tile = rem / 128, j = rem % 128; r0 = tile * 256 + half * 128 + j; }
#pragma unroll
    for (int j = 0; j < 4; ++j) { const int n = (lane >> 3) + 8 * j; const LAS float* s = scr + (8 * c) * 33 + n;
        v4u o; o.x = pk2(s[0 * 33], s[1 * 33]); o.y = pk2(s[2 * 33], s[3 * 33]); o.z = pk2(s[4 * 33], s[5 * 33]); o.w = pk2(s[6 * 33], s[7 * 33]);
        *(GAS v4u*)(WT + (size_t)(r0 + n) * K + k0 + 8 * c) = o; }
    LDS_WAIT(); asm volatile("" ::: "memory");
}

__device__ __forceinline__ void p0_prologue(Frame& F) {
    LAS float* scr = (LAS float*)(F.lds + RING_OFF + F.wave * 16384);
    const int gw = F.vcu * NWAVES + F.wave, NGW = F.G * NWAVES;
    const int lane = F.lane;
    for (int i = gw * 64 + lane; i < 4 * M; i += NGW * 64) F.ssv[i] = 0.f;
    constexpr int I_IN = (DM / 64) * (DIN / 32), I_OUT = (DM / 64) * (DM / 32), I_UP = (DM / 64) * (NUP / 32), I_DN = (DFF / 64) * (DM / 32);
    constexpr int NITEMS = I_IN + I_OUT + I_UP + I_DN;
    for (int it = gw; it < NITEMS; it += NGW) {
        int r = it;
        if (r < I_IN) { p0_transpose_item<0>(F.w_in, DM, DIN, F.Wt_in, nullptr, scr, r, lane); continue; } r -= I_IN;
        if (r < I_OUT) { const int kb = r / (DM / 32); p0_transpose_item<0>(F.w_out, DM, DM, F.Wt_out, (kb < 16) ? F.on_a_g : (F.on_b_g - 1024), scr, r, lane); continue; } r -= I_OUT;
        if (r < I_UP) { p0_transpose_item<1>(F.w_up, DM, NUP, F.Wt_up, F.norm2_g, scr, r, lane); continue; } r -= I_UP;
        p0_transpose_item<0>(F.w_down, DFF, DM, F.Wt_dn, nullptr, scr, r, lane);
    }
    for (int m = gw; m < M; m += NGW) {
        const GAS f32x4* xr = (const GAS f32x4*)(F.x + (size_t)m * DM) + lane;
        f32x4 v[8]; float s = 0.f;
#pragma unroll
        for (int j = 0; j < 8; ++j) { v[j] = xr[64 * j]; s += (v[j].x * v[j].x + v[j].y * v[j].y) + (v[j].z * v[j].z + v[j].w * v[j].w); }
        const float r = rsq(wave_sum(s) * (1.0f / DM) + EPS);
        GAS unsigned long long* o8 = (GAS unsigned long long*)(F.xn1 + (size_t)m * DM) + lane;
#pragma unroll
        for (int j = 0; j < 8; ++j) { const f32x4 g = ((const GAS f32x4*)F.norm1_g)[lane + 64 * j]; const f32x4 o = v[j] * r * g;
            o8[64 * j] = (unsigned long long)pk2(o.x, o.y) | ((unsigned long long)pk2(o.z, o.w) << 32); }
    }
    for (int t = gw; t < SEQ; t += NGW) {
        float z = 0.f;
        { const float tl = (float)t / (float)(SEQ - 1); const float w = (6.283185307179586f / (float)SEQ) * (float)t;
          if (lane == 0) z = tl;
          else if (lane <= 16) { const float f = 1e-4f + (float)(lane - 1) * ((15.0f - 1e-4f) / 15.0f); z = cosf(f * w); }
          else if (lane <= 32) { const float f = 1e-4f + (float)(lane - 17) * ((15.0f - 1e-4f) / 15.0f); z = -sinf(f * w); } }
        const float fr = F.f_freq[lane];
        float a = F.f_b1[lane];
        for (int k = 0; k < 33; ++k) a += __shfl(z, k) * F.f_w1[k * 64 + lane];
        float h = sinf(fr * a);
        a = F.f_b2[lane];
        for (int k = 0; k < 64; ++k) a += __shfl(h, k) * F.f_w2[k * 64 + lane];
        h = sinf(fr * a);
        a = F.f_b3[lane];
        for (int k = 0; k < 64; ++k) a += __shfl(h, k) * F.f_w3[k * 64 + lane];
        h = sinf(fr * a);
        F.h3[(size_t)t * 64 + lane] = h;
    }
}

__device__ __forceinline__ void sgu_unit(Frame& F, int unit) {
    const int h = unit & 7, pos0 = (unit >> 3) * 128;
    LAS unsigned char* As = F.lds; LAS unsigned char* Bs = F.lds + 128 * 272;
    const int t = F.tid, lane = F.lane, w = F.wave;
    {
        const int i = t >> 2, j0 = (t & 3) * 32;
        const GAS f32x4* wrow = (const GAS f32x4*)(F.sgu_w + ((size_t)h * 128 + i) * 128 + j0);
        const GAS f32x4* ssp = (const GAS f32x4*)(F.ssv + pos0 + j0);
#pragma unroll
        for (int q = 0; q < 4; ++q) { const f32x4 w0 = wrow[2 * q], w1 = wrow[2 * q + 1], s0 = ssp[2 * q], s1 = ssp[2 * q + 1];
            v4u o; o.x = pk2(w0.x * rsq(s0.x * (1.f / 1024.f) + EPS), w0.y * rsq(s0.y * (1.f / 1024.f) + EPS)); o.y = pk2(w0.z * rsq(s0.z * (1.f / 1024.f) + EPS), w0.w * rsq(s0.w * (1.f / 1024.f) + EPS));
            o.z = pk2(w1.x * rsq(s1.x * (1.f / 1024.f) + EPS), w1.y * rsq(s1.y * (1.f / 1024.f) + EPS)); o.w = pk2(w1.z * rsq(s1.z * (1.f / 1024.f) + EPS), w1.w * rsq(s1.w * (1.f / 1024.f) + EPS));
            *(LAS v4u*)(As + i * 272 + (j0 + 8 * q) * 2) = o; }
    }
    {
        const int d = t >> 2, c0 = (t & 3) * 32;
        const GAS v4u* src = (const GAS v4u*)(F.zvT + (size_t)(h * 128 + d) * M + pos0 + c0);
#pragma unroll
        for (int q = 0; q < 4; ++q) *(LAS v4u*)(Bs + d * 272 + (c0 + 8 * q) * 2) = src[q];
    }
    __syncthreads();
    const int iw = w & 3, dw = w >> 2, r = lane & 15, q = lane >> 4;
    f32x4 acc[2][4];
#pragma unroll
    for (int it = 0; it < 2; ++it)
#pragma unroll
        for (int dt = 0; dt < 4; ++dt) acc[it][dt] = (f32x4){0.f, 0.f, 0.f, 0.f};
#pragma unroll
    for (int ks = 0; ks < 4; ++ks) {
        bf16x8 a[2], b[4];
#pragma unroll
        for (int it = 0; it < 2; ++it) a[it] = *(const LAS bf16x8*)(As + (32 * iw + 16 * it + r) * 272 + (32 * ks + 8 * q) * 2);
#pragma unroll
        for (int dt = 0; dt < 4; ++dt) b[dt] = *(const LAS bf16x8*)(Bs + (64 * dw + 16 * dt + r) * 272 + (32 * ks + 8 * q) * 2);
#pragma unroll
        for (int it = 0; it < 2; ++it)
#pragma unroll
            for (int dt = 0; dt < 4; ++dt) acc[it][dt] = __builtin_amdgcn_mfma_f32_16x16x32_bf16(b[dt], a[it], acc[it][dt], 0, 0, 0);
    }
#pragma unroll
    for (int it = 0; it < 2; ++it) { const int i = 32 * iw + 16 * it + r, row = pos0 + i; const float bias = F.sgu_b[h * 128 + i]; float ss = 0.f;
#pragma unroll
        for (int dt = 0; dt < 4; ++dt) { const int col = h * 128 + 64 * dw + 16 * dt + 4 * q;
            const u32x2 zz = *(const GAS u32x2*)(F.zu + (size_t)row * DA + col);
            const float y0 = bflo(zz.x) * (acc[it][dt][0] + bias), y1 = bfhi(zz.x) * (acc[it][dt][1] + bias), y2 = bflo(zz.y) * (acc[it][dt][2] + bias), y3 = bfhi(zz.y) * (acc[it][dt][3] + bias);
            ss += (y0 * y0 + y1 * y1) + (y2 * y2 + y3 * y3);
            u32x2 o; o.x = pk2(y0, y1); o.y = pk2(y2, y3);
            *(GAS u32x2*)(F.mrg + (size_t)row * DM + col) = o; }
        ss += __shfl_xor(ss, 16); ss += __shfl_xor(ss, 32);
        if (q == 0) atomicAdd(F.ssa + row, ss); }
    __syncthreads();
}

__device__ __forceinline__ float dwc3(const bf16* p, int pos, int t, float w0, float w1, float w2, float b) {
    const float xm = (t > 0) ? bf2f(p[pos - 1]) : 0.f, xc = bf2f(p[pos]), xp = (t < SEQ - 1) ? bf2f(p[pos + 1]) : 0.f;
    return xm * w0 + xc * w1 + xp * w2 + b;
}
__device__ __forceinline__ void hyena_direct_unit(Frame& F, int c) {
    LAS float* kk = (LAS float*)F.lds; LAS float* u0 = kk + 16384; LAS float* u1 = u0 + 8192; LAS float* red = (LAS float*)(F.lds + RED_OFF);
    const int tid = F.tid;
    const float min_decay = logf(1e-2f) / 1.5f, max_decay = logf(1e-2f) / 0.3f;
    const float delta = fabsf(min_decay + (float)c * ((max_decay - min_decay) / 1023.0f));
    float l1 = 0.f;
    for (int d = tid; d < SEQ; d += 512) {
        const GAS f32x4* hrow = (const GAS f32x4*)(F.h3 + (size_t)d * 64);
        float sf = 0.f, sb = 0.f;
#pragma unroll 4
        for (int o4 = 0; o4 < 16; ++o4) { const f32x4 hv = hrow[o4];
            sf += hv.x * F.f_wout[(4 * o4 + 0) * 2048 + c] + hv.y * F.f_wout[(4 * o4 + 1) * 2048 + c] + hv.z * F.f_wout[(4 * o4 + 2) * 2048 + c] + hv.w * F.f_wout[(4 * o4 + 3) * 2048 + c];
            sb += hv.x * F.f_wout[(4 * o4 + 0) * 2048 + 1024 + c] + hv.y * F.f_wout[(4 * o4 + 1) * 2048 + 1024 + c] + hv.z * F.f_wout[(4 * o4 + 2) * 2048 + 1024 + c] + hv.w * F.f_wout[(4 * o4 + 3) * 2048 + 1024 + c]; }
        const float win = expf(-((float)d / (float)(SEQ - 1)) * delta);
        const float kf = sf * win, kb = sb * win;
        kk[SEQ + d] = kf; l1 += fabsf(kf);
        if (d >= 1) { kk[SEQ - d] = kb; l1 += fabsf(kb); } else kk[0] = 0.f;
    }
    l1 = wave_sum(l1);
    if (F.lane == 0) red[F.wave] = l1;
    const bf16* p0 = F.binT + (size_t)c * M; const bf16* p1 = F.binT + (size_t)(1024 + c) * M; const bf16* p2 = F.binT + (size_t)(2048 + c) * M;
    const float w00 = F.hy_conv_w[c], w01 = F.hy_conv_w[3072 + c], w02 = F.hy_conv_w[6144 + c], b0 = F.hy_conv_b[c];
    const float w10 = F.hy_conv_w[1024 + c], w11 = F.hy_conv_w[3072 + 1024 + c], w12 = F.hy_conv_w[6144 + 1024 + c], b1 = F.hy_conv_b[1024 + c];
    const float w20 = F.hy_conv_w[2048 + c], w21 = F.hy_conv_w[3072 + 2048 + c], w22 = F.hy_conv_w[6144 + 2048 + c], b2 = F.hy_conv_b[2048 + c];
    for (int pos = tid; pos < M; pos += 512) { const int t = pos & (SEQ - 1);
        const float bx1 = dwc3(p1, pos, t, w10, w11, w12, b1), bv = dwc3(p2, pos, t, w20, w21, w22, b2);
        ((pos >= SEQ) ? u1 : u0)[t] = bv * bx1; }
    __syncthreads();
    float tot = 0.f;
#pragma unroll
    for (int i = 0; i < NWAVES; ++i) tot += red[i];
    const float scale = 1.0f / (tot + EPS);
    float a0[16], a1[16];
#pragma unroll
    for (int j = 0; j < 16; ++j) { a0[j] = 0.f; a1[j] = 0.f; }
    const LAS float* kb_ = kk + tid + SEQ;
    for (int s = 0; s < SEQ; ++s) { const float ua = u0[s], ub = u1[s];
#pragma unroll
        for (int j = 0; j < 16; ++j) { const float kv = kb_[512 * j - s]; a0[j] += kv * ua; a1[j] += kv * ub; } }
    const float dsk = F.d_skip[c];
#pragma unroll
    for (int j = 0; j < 16; ++j) { const int t = tid + 512 * j;
        { const float yc = a0[j] * scale + u0[t] * dsk; const float bx0 = dwc3(p0, t, t, w00, w01, w02, b0); F.ybT[(size_t)c * M + t] = (bf16)f2bf(bx0 * yc); }
        { const float yc = a1[j] * scale + u1[t] * dsk; const float bx0 = dwc3(p0, SEQ + t, t, w00, w01, w02, b0); F.ybT[(size_t)c * M + SEQ + t] = (bf16)f2bf(bx0 * yc); } }
    __syncthreads();
}

__device__ __forceinline__ void p3_merge(Frame& F) {
    LAS unsigned char* T = F.lds;
    const int tid = F.tid, lane = F.lane, w = F.wave;
    for (int tile = F.vcu; tile < M / 64; tile += F.G) {
        const int pos0 = tile * 64;
#pragma unroll 4
        for (int k = 0; k < 16; ++k) { const int row = (tid >> 3) + 64 * k; const v4u v = *(const GAS v4u*)(F.ybT + (size_t)row * M + pos0 + (tid & 7) * 8);
            LAS unsigned* dst = (LAS unsigned*)(T + row * 132 + (tid & 7) * 16); dst[0] = v.x; dst[1] = v.y; dst[2] = v.z; dst[3] = v.w; }
        __syncthreads();
        for (int i = 0; i < 8; ++i) { const int p = w * 8 + i; float a[8], b[8]; float s = 0.f;
#pragma unroll
            for (int k = 0; k < 8; ++k) { const int c = 2 * lane + 128 * k;
                a[k] = bf2f(*(const LAS unsigned short*)(T + c * 132 + p * 2)); b[k] = bf2f(*(const LAS unsigned short*)(T + (c + 1) * 132 + p * 2)); s += a[k] * a[k] + b[k] * b[k]; }
            s = wave_sum(s);
            const float rb = rsq(s * (1.f / 1024.f) + EPS), ra = rsq(F.ssa[pos0 + p] * (1.f / 1024.f) + EPS), sc = rb / ra;
#pragma unroll
            for (int k = 0; k < 8; ++k) *(GAS unsigned*)(F.mrg + (size_t)(pos0 + p) * DM + 1024 + 2 * lane + 128 * k) = pk2(a[k] * sc, b[k] * sc); }
        __syncthreads();
    }
}

__device__ __forceinline__ void p_convglu(Frame& F, int half) {
    const int gt = F.vcu * 512 + F.tid, NT = F.G * 512;
    constexpr int CH8 = DFF / 8;
    for (int it = gt; it < SEQ * CH8; it += NT) { const int t = it / CH8, c8 = it % CH8, ch = c8 * 8, tile = ch >> 7, j = ch & 127;
        const bf16* gp = F.gvh + (size_t)t * NUP + tile * 256 + j;
        const v4u gc = *(const GAS v4u*)gp, vv = *(const GAS v4u*)(gp + 128);
        v4u gm = (v4u){0u, 0u, 0u, 0u}, gn = (v4u){0u, 0u, 0u, 0u};
        if (t > 0) gm = *(const GAS v4u*)(gp - NUP);
        if (t < SEQ - 1) gn = *(const GAS v4u*)(gp + NUP);
        const f32x4 w0a = *(const GAS f32x4*)(F.dw_w + ch), w0b = *(const GAS f32x4*)(F.dw_w + ch + 4), w1a = *(const GAS f32x4*)(F.dw_w + DFF + ch), w1b = *(const GAS f32x4*)(F.dw_w + DFF + ch + 4);
        const f32x4 w2a = *(const GAS f32x4*)(F.dw_w + 2 * DFF + ch), w2b = *(const GAS f32x4*)(F.dw_w + 2 * DFF + ch + 4), ba = *(const GAS f32x4*)(F.dw_b + ch), bb = *(const GAS f32x4*)(F.dw_b + ch + 4);
        float o[8];
        const unsigned gmw[4] = {gm.x, gm.y, gm.z, gm.w}, gcw[4] = {gc.x, gc.y, gc.z, gc.w}, gnw[4] = {gn.x, gn.y, gn.z, gn.w}, vw[4] = {vv.x, vv.y, vv.z, vv.w};
        const float w0[8] = {w0a.x, w0a.y, w0a.z, w0a.w, w0b.x, w0b.y, w0b.z, w0b.w}, w1[8] = {w1a.x, w1a.y, w1a.z, w1a.w, w1b.x, w1b.y, w1b.z, w1b.w};
        const float w2[8] = {w2a.x, w2a.y, w2a.z, w2a.w, w2b.x, w2b.y, w2b.z, w2b.w}, bbv[8] = {ba.x, ba.y, ba.z, ba.w, bb.x, bb.y, bb.z, bb.w};
#pragma unroll
        for (int e = 0; e < 8; ++e) { const int wi = e >> 1; const bool hi = e & 1;
            const float g0 = hi ? bfhi(gmw[wi]) : bflo(gmw[wi]), g1 = hi ? bfhi(gcw[wi]) : bflo(gcw[wi]), g2 = hi ? bfhi(gnw[wi]) : bflo(gnw[wi]), v = hi ? bfhi(vw[wi]) : bflo(vw[wi]);
            o[e] = gelu_f(g0 * w0[e] + g1 * w1[e] + g2 * w2[e] + bbv[e]) * v; }
        v4u ov; ov.x = pk2(o[0], o[1]); ov.y = pk2(o[2], o[3]); ov.z = pk2(o[4], o[5]); ov.w = pk2(o[6], o[7]);
        *(GAS v4u*)(F.hb + (size_t)(half * SEQ + t) * DFF + ch) = ov; }
}

__device__ __forceinline__ void p_final(Frame& F) {
    const int gw = F.vcu * NWAVES + F.wave, NGW = F.G * NWAVES, lane = F.lane;
    for (int m = gw; m < M; m += NGW) {
        const float r = rsq(F.ss3[m] * (1.0f / DM) + EPS);
        GAS f32x4* xr = (GAS f32x4*)(F.out + (size_t)m * DM) + lane;
#pragma unroll
        for (int j = 0; j < 8; ++j) { const f32x4 g = ((const GAS f32x4*)F.final_g)[lane + 64 * j]; xr[64 * j] = xr[64 * j] * r * g; }
    }
}

constexpr int NPHASE = 11;
template <int PHMASK> __global__ void __launch_bounds__(NWAVES * 64, 2) fwd_kernel(Args args) {
    extern __shared__ __attribute__((aligned(16))) unsigned char lds[];
    Frame F;
    F.lds = (LAS unsigned char*)lds;
    F.MISC = (volatile LAS unsigned*)(F.lds + MISC_OFF);
    F.tid = threadIdx.x; F.lane = F.tid & 63; F.wave = __builtin_amdgcn_readfirstlane(F.tid >> 6);
    F.G = gridDim.x; { const int bx = blockIdx.x; F.vcu = (F.G % 8 == 0) ? (bx % 8) * (F.G / 8) + bx / 8 : bx; }
    F.ctl = (gu32*)(args.ws + WS_CTL);
    for (int u = F.tid; u < (LDS_BYTES - LDSCTL_OFF) / 4; u += NWAVES * 64) ((LAS unsigned*)(F.lds + LDSCTL_OFF))[u] = 0u;
    __syncthreads();
    const int lo = args.ph_lo, hi = args.ph_hi;
    XcdBarrier bar; bar.bar = (unsigned*)(F.ctl + CW_BAR) + args.li * XCD_BAR_WORDS; bar.x = 0; bar.st = nullptr;
    if (hi - lo > 1) bar = xcd_barrier_post((unsigned*)(F.ctl + CW_BAR) + args.li * XCD_BAR_WORDS, F.MISC + 8);
#define IN(k) (((PHMASK >> (k)) & 1) && lo <= (k) && (k) < hi)
#define SEAM(k) do { if (IN(k) && IN((k) + 1)) xcd_barrier(bar); } while (0)

    if (IN(0)) { frame_ptrs(F); p0_prologue(F); }
    SEAM(0);
    if (IN(1)) {
        frame_ptrs(F);
        {
            pg8::Gemm g{F.xn1, F.Wt_in, M, DA, DM}; pg8::StaticOrder S; S.init(M, DA, F.G, (int)blockIdx.x);
            pg8::EpiBf16<1> E{F.zu, DA, nullptr, 0, 0, 1.f};
            pg8::gemm_phase<pg8::EpiBf16<1>, pg8::StaticOrder, PG8_ALIGN, PG8_SP2>(F.lds + RING_OFF, g, S, E); }
        {
            pg8::Gemm g{F.Wt_in + (size_t)DA * DM, F.xn1, DIN - DA, M, DM}; pg8::StaticOrder S; S.init(DIN - DA, M, F.G, (int)blockIdx.x);
            pg8::Epi1b E{F.zvT, F.binT, F.sgu_norm_g, F.ssv};
            pg8::gemm_phase<pg8::Epi1b, pg8::StaticOrder, PG8_ALIGN, PG8_SP2>(F.lds + RING_OFF, g, S, E); }
    }
    SEAM(1);
    if (IN(2)) {
        frame_ptrs(F);
        for (int u = F.vcu; u < BATCH * (SEQ / 128) * NHA; u += F.G) sgu_unit(F, u);
        for (int c = F.vcu; c < DB; c += F.G) hyena_direct_unit(F, c);
    }
    SEAM(2);
    if (IN(3)) { frame_ptrs(F); p3_merge(F); }
    SEAM(3);
    if (IN(4)) { frame_ptrs(F);
        pg8::Gemm g{F.mrg, F.Wt_out, M, DM, DM}; pg8::StaticOrder S; S.init(M, DM, F.G, (int)blockIdx.x);
        pg8::Epi2 E{F.x, F.out, F.xb2, F.ssa, F.ss2};
        pg8::gemm_phase<pg8::Epi2, pg8::StaticOrder, PG8_ALIGN, PG8_SP2>(F.lds + RING_OFF, g, S, E);
    }
    SEAM(4);
#pragma unroll 1
    for (int half = 0; half < 2; ++half) {
        if (IN(5 + 2 * half)) { frame_ptrs(F);
            pg8::Gemm g{F.xb2 + (size_t)half * SEQ * DM, F.Wt_up, SEQ, NUP, DM}; pg8::StaticOrder S; S.init(SEQ, NUP, F.G, (int)blockIdx.x);
            pg8::Epi3raw E{F.gvh, F.ss2, half * SEQ};
            pg8::gemm_phase<pg8::Epi3raw, pg8::StaticOrder, PG8_ALIGN, PG8_SP2>(F.lds + RING_OFF, g, S, E);
        }
        SEAM(5 + 2 * half);
        if (IN(6 + 2 * half)) { frame_ptrs(F); p_convglu(F, half); }
        SEAM(6 + 2 * half);
    }
    if (IN(9)) { frame_ptrs(F);
        pg8::Gemm g{F.hb, F.Wt_dn, M, DM, DFF}; pg8::StaticOrder S; S.init(M, DM, F.G, (int)blockIdx.x);
        pg8::Epi4 E{F.out, F.ss3};
        pg8::gemm_phase<pg8::Epi4, pg8::StaticOrder, PG8_ALIGN, PG8_SP2>(F.lds + RING_OFF, g, S, E);
    }
    SEAM(9);
    if (IN(10)) { frame_ptrs(F); p_final(F); }
#undef IN
#undef SEAM
}

#ifndef MK_LAUNCHES
#define MK_LAUNCHES 11
#endif
template <int MASK> static bool launch_phases(int grid, Args a, int lo, int hi, hipStream_t stream) {
    static bool attr_done = false;
    if (!attr_done) { if (hipFuncSetAttribute((const void*)fwd_kernel<MASK>, hipFuncAttributeMaxDynamicSharedMemorySize, LDS_BYTES) != hipSuccess) { fprintf(stderr, "kernel_launch: hipFuncSetAttribute failed\n"); return false; } attr_done = true; }
    a.ph_lo = lo; a.ph_hi = hi; a.li = 0;
    hipLaunchKernelGGL(fwd_kernel<MASK>, dim3(grid), dim3(NWAVES * 64), LDS_BYTES, stream, a);
    return true;
}
extern "C" void kernel_launch(void* const* d_in, const int* in_sizes, int n_in, void* d_out, int out_size, void* d_ws, size_t ws_size, hipStream_t stream) {
    static int grid = 0;
    if (grid == 0) {
        if (n_in != 26 || out_size != M * DM || ws_size < WS_END) { fprintf(stderr, "kernel_launch: unexpected shapes: n_in %d out %d ws %zu\n", n_in, out_size, ws_size); grid = -1; return; }
        int dev = 0, cus = 0;
        if (hipGetDevice(&dev) != hipSuccess || hipDeviceGetAttribute(&cus, hipDeviceAttributeMultiprocessorCount, dev) != hipSuccess) { grid = -1; return; }
        (void)hipGetLastError();
        grid = cus;
    }
    if (grid < 0) return;
    (void)hipMemsetAsync((char*)d_ws + WS_CTL, 0, CTL_ZERO_BYTES, stream);
    Args a{};
    for (int i = 0; i < 26; ++i) a.in[i] = (const float*)d_in[i];
    a.out = (float*)d_out; a.ws = (unsigned char*)d_ws;
#if MK_LAUNCHES == 1
    launch_phases<0x7FF>(grid, a, 0, NPHASE, stream);
#else
    launch_phases<0x001>(grid, a, 0, 1, stream);
    launch_phases<0x002>(grid, a, 1, 2, stream);
    launch_phases<0x004>(grid, a, 2, 3, stream);
    launch_phases<0x008>(grid, a, 3, 4, stream);
    launch_phases<0x010>(grid, a, 4, 5, stream);
    launch_phases<0x0A0>(grid, a, 5, 6, stream);
    launch_phases<0x140>(grid, a, 6, 7, stream);
    launch_phases<0x0A0>(grid, a, 7, 8, stream);
    launch_phases<0x140>(grid, a, 8, 9, stream);
    launch_phases<0x200>(grid, a, 9, 10, stream);
    launch_phases<0x400>(grid, a, 10, 11, stream);
#endif
}
```

```cpp
#include <hip/hip_runtime.h>
#include <cstdio>
#include <cstdint>
namespace pg8 {
#define PG8_LAS __attribute__((address_space(3)))
typedef unsigned short bf16_t;
typedef short bf16x8 __attribute__((ext_vector_type(8)));
typedef float f32x4 __attribute__((ext_vector_type(4)));
typedef unsigned u32x4 __attribute__((ext_vector_type(4)));
constexpr int BM = 256, BK = 64, HALF = 128, HTB = HALF * BK * 2  , STAGE_BYTES = 8 * HTB, NXCD = 8, WGM = 8;

__host__ __device__ __forceinline__ int lds_byte(int r, int c) { const int st = (r >> 4) * 2 + (c >> 5), rr = r & 15, cc = c & 31, ob = rr * 64 + cc * 2; return st * 1024 + (ob ^ (((ob >> 9) & 1) << 5)); }
__host__ __device__ __forceinline__ void stage_rc(int b, int& R, int& C) { const int st = b / 1024, sb = b % 1024, swz = sb ^ (((sb >> 9) & 1) << 5); R = (st >> 1) * 16 + swz / 64; C = (st & 1) * 32 + (swz % 64) / 2; }
__host__ __device__ __forceinline__ int perm32(int rho) { const int n = rho >> 4, i = rho & 15; return 8 * (i >> 2) + 4 * n + (i & 3); }

struct Unit { int pm, pn; };
struct Gemm { const bf16_t* A; const bf16_t* Bt; int M, N, K; int a_rows = 256; };

struct StaticOrder {
    int nM, nN, nwg, G, c;
    __host__ __device__ void init(int M, int N, int G_, int c_) { nM = M / BM; nN = N / BM; nwg = nM * nN; G = G_; c = c_; }
    __host__ __device__ void init_tiles(int nM_, int nN_, int G_, int c_) { nM = nM_; nN = nN_; nwg = nM * nN; G = G_; c = c_; }
    __host__ __device__ bool next(int i, Unit& u) const {
        const long L = (long)i * G + c; if (L >= nwg) return false;
        int wgid = (int)L; { const int q = nwg / NXCD, r = nwg % NXCD, xcd = wgid % NXCD, off = wgid / NXCD; wgid = (xcd < r ? xcd * (q + 1) : r * (q + 1) + (xcd - r) * q) + off; }
        const int nig = WGM * nN, gid = wgid / nig, fm = gid * WGM, gsz = (nM - fm) < WGM ? (nM - fm) : WGM;
        u.pm = fm + ((wgid % nig) % gsz); u.pn = (wgid % nig) / gsz; return true;
    }
    __device__ __forceinline__ void a_ready(const Unit&) const {}
    __device__ __forceinline__ void done(const Unit&) const {}
};

__device__ __forceinline__ unsigned cvt_pk_bf16(float lo, float hi) { unsigned r; asm volatile("v_cvt_pk_bf16_f32 %0, %1, %2" : "=v"(r) : "v"(lo), "v"(hi)); return r; }
typedef float f32x2 __attribute__((ext_vector_type(2)));
__device__ __forceinline__ f32x2 gelu_pk(f32x2 v) {
    const f32x2 av = __builtin_elementwise_abs(v), d = av * 0.2316418882f + 1.0f;
    f32x2 t; t.x = __builtin_amdgcn_rcpf(d.x); t.y = __builtin_amdgcn_rcpf(d.y);
    f32x2 q = t * 0.5307027145f + (-0.7265760135f); q = q * t + 0.7107068705f; q = q * t + (-0.142248368f); q = q * t + 0.127414796f; q = q * t;
    const f32x2 s = (v * v) * (-0.72134752044f);
    f32x2 e; e.x = __builtin_amdgcn_exp2f(s.x); e.y = __builtin_amdgcn_exp2f(s.y);
    const f32x2 m = v * (q * e), r = v - m;
    f32x2 o; o.x = v.x < 0.f ? m.x : r.x; o.y = v.y < 0.f ? m.y : r.y; return o;
}

template <int ACT  > struct EpiBf16 {
    static constexpr bool PERM = true, AFTER_DRAIN = false; static_assert(ACT == 0 || ACT == 1, "EpiBf16: ACT is 0 (none) or 1 (gelu_pk)");
    bf16_t* O; int ldc; const float* bias; int split_cols; size_t split_stride; float scale0;
    __device__ __forceinline__ void operator()(const f32x4 (&acc)[2][2][4][2], const Unit& u, int wr, int wc, int fr, int fq) const {
        const int row0 = u.pm * BM + wr * 64 + fr; int colt = u.pn * BM; bf16_t* base = O;
        float sc = 1.f; if (split_cols) { const int t = colt / split_cols; base += (size_t)t * split_stride; colt -= t * split_cols; if (t == 0) sc = scale0; }
        const int col0 = colt + wc * 32 + 8 * fq, bcol0 = u.pn * BM + wc * 32 + 8 * fq;
        f32x4 bv[2][2];
#pragma unroll
        for (int bj = 0; bj < 2; ++bj)
#pragma unroll
            for (int n = 0; n < 2; ++n) bv[bj][n] = bias ? *(const f32x4*)(bias + bcol0 + bj * HALF + 4 * n) : (f32x4){0.f, 0.f, 0.f, 0.f};
#pragma unroll
        for (int ai = 0; ai < 2; ++ai)
#pragma unroll
            for (int m = 0; m < 4; ++m) { bf16_t* rowp = base + (size_t)(row0 + ai * HALF + m * 16) * ldc + col0;
#pragma unroll
                for (int bj = 0; bj < 2; ++bj) { f32x4 v0 = acc[ai][bj][m][0] + bv[bj][0], v1 = acc[ai][bj][m][1] + bv[bj][1];
                    if (ACT == 1) { f32x2 a = gelu_pk((f32x2){v0[0], v0[1]}), b = gelu_pk((f32x2){v0[2], v0[3]}), c = gelu_pk((f32x2){v1[0], v1[1]}), d = gelu_pk((f32x2){v1[2], v1[3]});
                        v0 = (f32x4){a.x, a.y, b.x, b.y}; v1 = (f32x4){c.x, c.y, d.x, d.y}; }
                    v0 = v0 * sc; v1 = v1 * sc; u32x4 w; w.x = cvt_pk_bf16(v0[0], v0[1]); w.y = cvt_pk_bf16(v0[2], v0[3]); w.z = cvt_pk_bf16(v1[0], v1[1]); w.w = cvt_pk_bf16(v1[2], v1[3]);
                    *(u32x4*)(rowp + bj * HALF) = w; } }
    }
};
template <class Epi, class Sched, bool ALIGN_EPI = false, bool SP2 = false>
__device__ __forceinline__ void gemm_phase(PG8_LAS unsigned char* lds, const Gemm g, const Sched& S, const Epi& E) {
    int tid_ = threadIdx.x; asm volatile("" : "+v"(tid_));
    const int tid = tid_, wid = __builtin_amdgcn_readfirstlane(tid >> 6), lane = tid & 63, wr = wid >> 2, wc = wid & 3, fr = lane & 15, fq = lane >> 4;
    const int K = g.K, nt = K / BK;
    unsigned voffA[2], voffB[2];
#pragma unroll
    for (int i = 0; i < 2; ++i) { int R, C; stage_rc(tid * 16 + i * 8192, R, C); const int Rb = Epi::PERM ? ((R & ~31) + perm32(R & 31)) : R;
        voffA[i] = (unsigned)(R * K + C) * 2u; voffB[i] = (unsigned)(Rb * K + C) * 2u; }
    const size_t kstep = (size_t)(BK * 2);
    const size_t hstep = (size_t)HALF * K * 2;
    const size_t tstep = 2 * hstep;
    const size_t astep = (size_t)g.a_rows * K * 2;
    const unsigned ldsw = (unsigned)wid * 1024u;
    const int aoff = lds_byte(wr * 64 + fr, fq * 8), boff = lds_byte(wc * 32 + fr, fq * 8);
#define PG8_SA(b, h) (((b) * 2 + (h)) * HTB)
#define PG8_SB(b, h) ((4 + (b) * 2 + (h)) * HTB)
#define PG8_STAGE(bufoff, gbase, voff) do { _Pragma("unroll") for (int _i = 0; _i < 2; ++_i) \
        __builtin_amdgcn_global_load_lds((const unsigned*)((const char*)(gbase) + (voff)[_i]), (PG8_LAS unsigned*)(lds + (bufoff) + ldsw + _i * 8192), 16, 0, 0); } while (0)
#define PG8_LDA(dst, b, h) do { _Pragma("unroll") for (int m = 0; m < 4; ++m) _Pragma("unroll") for (int k = 0; k < 2; ++k) dst[m][k] = *(const PG8_LAS bf16x8*)(lds + PG8_SA(b, h) + aoff + m * 2048 + k * 1024); } while (0)
#define PG8_LDB(dst, b, h) do { _Pragma("unroll") for (int n = 0; n < 2; ++n) _Pragma("unroll") for (int k = 0; k < 2; ++k) dst[n][k] = *(const PG8_LAS bf16x8*)(lds + PG8_SB(b, h) + boff + n * 2048 + k * 1024); } while (0)
#define PG8_MMA(ai, bj, At, Bt) do { __builtin_amdgcn_s_setprio(1); _Pragma("unroll") for (int m = 0; m < 4; ++m) _Pragma("unroll") for (int n = 0; n < 2; ++n) _Pragma("unroll") for (int k = 0; k < 2; ++k) \
        acc[ai][bj][m][n] = __builtin_amdgcn_mfma_f32_16x16x32_bf16(Bt[n][k], At[m][k], acc[ai][bj][m][n], 0, 0, 0); __builtin_amdgcn_s_setprio(0); } while (0)
#define PG8_WAIT_V(n) asm volatile("s_waitcnt vmcnt(" #n ")" ::: "memory")
#define PG8_WAIT_L(n) asm volatile("s_waitcnt lgkmcnt(" #n ")" ::: "memory")
#define PG8_BAR __builtin_amdgcn_s_barrier()
#define PG8_SCHED __builtin_amdgcn_sched_barrier(0)
    Unit cur, nxt; int ui = 0;
    if (!S.next(0, cur)) return;
    f32x4 acc[2][2][4][2];
#pragma unroll
    for (int a = 0; a < 2; ++a)
#pragma unroll
        for (int b = 0; b < 2; ++b)
#pragma unroll
            for (int m = 0; m < 4; ++m)
#pragma unroll
                for (int n = 0; n < 2; ++n) acc[a][b][m][n] = (f32x4){0.f, 0.f, 0.f, 0.f};
    bf16x8 At[4][2], B0[2][2], B1[2][2];
    const char* cA = (const char*)g.A + (size_t)cur.pm * astep; const char* cB = (const char*)g.Bt + (size_t)cur.pn * tstep;
    S.a_ready(cur);
    if constexpr (SP2) {
        PG8_STAGE(PG8_SB(0, 0), cB, voffB); PG8_STAGE(PG8_SB(0, 1), cB + hstep, voffB); PG8_STAGE(PG8_SA(0, 0), cA, voffA); PG8_STAGE(PG8_SA(0, 1), cA + hstep, voffA);
        if (wr == 1) PG8_BAR;
        PG8_WAIT_V(2); PG8_BAR;
        PG8_STAGE(PG8_SB(1, 0), cB + kstep, voffB); PG8_STAGE(PG8_SA(1, 0), cA + kstep, voffA); PG8_STAGE(PG8_SB(1, 1), cB + hstep + kstep, voffB);
        PG8_WAIT_V(6); PG8_BAR;
    } else {
        PG8_STAGE(PG8_SB(0, 0), cB, voffB); PG8_STAGE(PG8_SA(0, 0), cA, voffA); PG8_STAGE(PG8_SB(0, 1), cB + hstep, voffB); PG8_STAGE(PG8_SA(0, 1), cA + hstep, voffA);
        if (wr == 1) PG8_BAR;
        PG8_WAIT_V(4); PG8_BAR;
        PG8_STAGE(PG8_SB(1, 0), cB + kstep, voffB); PG8_STAGE(PG8_SA(1, 0), cA + kstep, voffA); PG8_STAGE(PG8_SB(1, 1), cB + hstep + kstep, voffB);
        PG8_WAIT_V(6); PG8_BAR;
    }
    for (;;) {
        const bool has_next = S.next(ui + 1, nxt);
        const char* nA = has_next ? (const char*)g.A + (size_t)nxt.pm * astep : cA; const char* nB = has_next ? (const char*)g.Bt + (size_t)nxt.pn * tstep : cB;
        for (int t = 0; t < nt; t += 2) {
            const bool last = (t == nt - 2);
            const char* a1 = cA + (size_t)(t + 1) * kstep;
            const char* a2 = last ? nA : cA + (size_t)(t + 2) * kstep; const char* b2 = last ? nB : cB + (size_t)(t + 2) * kstep;
            const char* a3 = a2 + kstep; const char* b3 = b2 + kstep;
            if (last && has_next) S.a_ready(nxt);
            if constexpr (SP2) {
            PG8_LDB(B0, 0, 0); PG8_LDB(B1, 0, 1); PG8_SCHED; PG8_LDA(At, 0, 0); PG8_STAGE(PG8_SA(1, 1), a1 + hstep, voffA);
            PG8_WAIT_V(8); PG8_WAIT_L(0); PG8_BAR; PG8_MMA(0, 0, At, B0); PG8_MMA(0, 1, At, B1); PG8_BAR; PG8_SCHED;
            PG8_LDA(At, 0, 1); PG8_STAGE(PG8_SB(0, 0), b2, voffB); PG8_STAGE(PG8_SB(0, 1), b2 + hstep, voffB); PG8_STAGE(PG8_SA(0, 0), a2, voffA);
            PG8_WAIT_V(8); PG8_WAIT_L(0); PG8_BAR; PG8_MMA(1, 0, At, B0); PG8_MMA(1, 1, At, B1); PG8_BAR; PG8_SCHED;
            PG8_LDB(B0, 1, 0); PG8_LDB(B1, 1, 1); PG8_SCHED; PG8_LDA(At, 1, 0); PG8_STAGE(PG8_SA(0, 1), a2 + hstep, voffA);
            PG8_WAIT_V(8); PG8_WAIT_L(0); PG8_BAR; PG8_MMA(0, 0, At, B0); PG8_MMA(0, 1, At, B1); PG8_BAR; PG8_SCHED;
            PG8_LDA(At, 1, 1); PG8_STAGE(PG8_SB(1, 0), b3, voffB); PG8_STAGE(PG8_SB(1, 1), b3 + hstep, voffB); PG8_STAGE(PG8_SA(1, 0), a3, voffA);
            PG8_WAIT_V(8); PG8_WAIT_L(0); PG8_BAR; PG8_MMA(1, 0, At, B0); PG8_MMA(1, 1, At, B1); PG8_BAR; PG8_SCHED;
            } else {
            PG8_LDB(B0, 0, 0); PG8_SCHED; PG8_LDA(At, 0, 0); PG8_STAGE(PG8_SA(1, 1), a1 + hstep, voffA);
            PG8_WAIT_L(8); PG8_BAR; PG8_WAIT_L(0); PG8_MMA(0, 0, At, B0); PG8_BAR; PG8_SCHED;
            PG8_LDB(B1, 0, 1); PG8_STAGE(PG8_SB(0, 0), b2, voffB);
            PG8_BAR; PG8_WAIT_L(0); PG8_MMA(0, 1, At, B1); PG8_BAR;
            PG8_LDA(At, 0, 1); PG8_STAGE(PG8_SA(0, 0), a2, voffA);
            PG8_BAR; PG8_WAIT_L(0); PG8_MMA(1, 0, At, B0); PG8_BAR; PG8_SCHED;
            PG8_STAGE(PG8_SB(0, 1), b2 + hstep, voffB);
            PG8_WAIT_V(6); PG8_BAR; PG8_MMA(1, 1, At, B1); PG8_BAR;
            PG8_LDB(B0, 1, 0); PG8_SCHED; PG8_LDA(At, 1, 0); PG8_STAGE(PG8_SA(0, 1), a2 + hstep, voffA);
            PG8_WAIT_L(8); PG8_BAR; PG8_WAIT_L(0); PG8_MMA(0, 0, At, B0); PG8_BAR; PG8_SCHED;
            PG8_LDB(B1, 1, 1); PG8_STAGE(PG8_SB(1, 0), b3, voffB);
            PG8_BAR; PG8_WAIT_L(0); PG8_MMA(0, 1, At, B1); PG8_BAR;
            PG8_LDA(At, 1, 1); PG8_STAGE(PG8_SA(1, 0), a3, voffA);
            PG8_BAR; PG8_WAIT_L(0); PG8_MMA(1, 0, At, B0); PG8_BAR; PG8_SCHED;
            PG8_STAGE(PG8_SB(1, 1), b3 + hstep, voffB);
            PG8_WAIT_V(6); PG8_BAR; PG8_MMA(1, 1, At, B1); PG8_BAR;
            }
        }
        if constexpr (ALIGN_EPI) { if (wr == 0) PG8_BAR; }
        if constexpr (!Epi::AFTER_DRAIN) { E(acc, cur, wr, wc, fr, fq); S.done(cur); }
        if (!has_next) break;
#pragma unroll
        for (int a = 0; a < 2; ++a)
#pragma unroll
            for (int b = 0; b < 2; ++b)
#pragma unroll
                for (int m = 0; m < 4; ++m)
#pragma unroll
                    for (int n = 0; n < 2; ++n) acc[a][b][m][n] = (f32x4){0.f, 0.f, 0.f, 0.f};
        cur = nxt; cA = nA; cB = nB; ++ui;
        if constexpr (ALIGN_EPI) { if (wr == 1) PG8_BAR; }
    }
    PG8_WAIT_V(0);
    if constexpr (!ALIGN_EPI) { if (wr == 0) PG8_BAR; }
    PG8_BAR;
    if constexpr (Epi::AFTER_DRAIN) { E.fused(acc, cur, wr, wc, fr, fq, lds, wid, lane); S.done(cur); }
#undef PG8_SA
#undef PG8_SB
#undef PG8_STAGE
#undef PG8_LDA
#undef PG8_LDB
#undef PG8_MMA
#undef PG8_WAIT_V
#undef PG8_WAIT_L
#undef PG8_BAR
#undef PG8_SCHED
}
}

#ifndef PG8_SP2
#define PG8_SP2 true
#endif
#ifndef PG8_ALIGN
#define PG8_ALIGN true
#endif

constexpr int NWAVES = 8;
constexpr int BATCH = 2, SEQ = 8192, DM = 2048, M = BATCH * SEQ;
constexpr int DA = 1024, DB = 1024, NHA = 8, DIN = 5120, DFF = 5504, NUP = 2 * DFF;
constexpr float EPS = 1e-6f;
constexpr int FORD = 64;

constexpr size_t MiB = 1u << 20;
constexpr size_t WS_CTL = 0, CTL_ZERO_BYTES = 65536;
constexpr size_t WS_SS = 1 * MiB;
constexpr size_t WS_WIN = 2 * MiB, WS_WOUT = 22 * MiB, WS_WUP = 30 * MiB, WS_WDN = 73 * MiB;
constexpr size_t WS_XN1 = 96 * MiB, WS_ZU = 160 * MiB, WS_ZVT = 192 * MiB, WS_BINT = 224 * MiB;
constexpr size_t WS_H3 = 320 * MiB, WS_HT = 322 * MiB, WS_YBT = 386 * MiB, WS_MRG = 418 * MiB;
constexpr size_t WS_H = 96 * MiB;
constexpr size_t WS_XB2 = 269 * MiB;
constexpr size_t WS_GVH = 336 * MiB;
constexpr size_t WS_KBUF = 96 * MiB;
constexpr size_t WS_DUMOUT = 336 * MiB;
constexpr size_t WS_END = 508 * MiB;
constexpr int CW_TMO = 0, CW_CODE = 1, CW_BAR = 4096;

constexpr int RING_OFF = 0, RING_BYTES = 131072;
constexpr int LDS_BYTES = 163840;
constexpr int LDSCTL_OFF = LDS_BYTES - 1024, MISC_OFF = LDSCTL_OFF + 320;
constexpr int RED_OFF = MISC_OFF + 128;
static_assert(RED_OFF + 256 <= LDS_BYTES, "LDS map");

#define GAS __attribute__((address_space(1)))
#define LAS __attribute__((address_space(3)))
typedef unsigned short bf16;
typedef unsigned v4u __attribute__((ext_vector_type(4)));
typedef float f32x4 __attribute__((ext_vector_type(4)));
typedef short bf16x8 __attribute__((ext_vector_type(8)));
typedef GAS unsigned gu32;
typedef GAS unsigned long long gu64;
#define RLX_AGENT __ATOMIC_RELAXED, __HIP_MEMORY_SCOPE_AGENT
#define LDS_WAIT() asm volatile("s_waitcnt lgkmcnt(0)" ::: "memory")
#define VM_WAIT() asm volatile("s_waitcnt vmcnt(0)" ::: "memory")
__device__ __forceinline__ unsigned long long rt() { return __builtin_amdgcn_s_memrealtime(); }
__device__ __forceinline__ unsigned f2bf(float f) { unsigned u = __builtin_bit_cast(unsigned, f); return (u + 0x7fffu + ((u >> 16) & 1u)) >> 16; }
__device__ __forceinline__ unsigned pk2(float lo, float hi) { return f2bf(lo) | (f2bf(hi) << 16); }

#define XB_TMO      128
#define XB_XCNT(j)  (256  + 64 * (j))
#define XB_XSUB(j)  (1280 + 64 * (j))
#define XB_XGEN(j)  (2304 + 64 * (j))
#define XB_TOP      3328
#define XB_TOPGEN   3392
#define XCD_BAR_WORDS 3456
#define XB_SPIN_CAP (1u << 18)

__device__ __forceinline__ unsigned xb_ld(unsigned* p)              { return __hip_atomic_load(p, __ATOMIC_RELAXED, __HIP_MEMORY_SCOPE_AGENT); }
__device__ __forceinline__ unsigned xb_add(unsigned* p, unsigned v) { return __hip_atomic_fetch_add(p, v, __ATOMIC_RELAXED, __HIP_MEMORY_SCOPE_AGENT); }
__device__ __forceinline__ unsigned xb_xcc_id() { return (unsigned)__builtin_amdgcn_s_getreg((3 << 11) | 20) & 0xFu; }
#define XB_SPIN(cond, bar) do { unsigned _sp = 0; while (cond) { __builtin_amdgcn_s_sleep(1); \
    if ((++_sp & 255u) == 0u) { if (xb_ld(&(bar)[XB_TMO])) break; if (_sp > XB_SPIN_CAP) { atomicAdd(&(bar)[XB_TMO], 1u); break; } } } } while (0)

struct XcdBarrier {
    unsigned* bar; unsigned x;
    volatile LAS unsigned* st;
};

__device__ __forceinline__ XcdBarrier xcd_barrier_post(unsigned* bar, volatile LAS unsigned* st) {
    XcdBarrier b; b.bar = bar; b.x = xb_xcc_id(); b.st = st;
    if (threadIdx.x == 0) (void)xb_add(&bar[XB_XCNT(b.x)], 1u);
    return b;
}
__device__ __forceinline__ void xcd_barrier_complete(unsigned* bar, unsigned x, unsigned& nloc, unsigned& nx) {
    const unsigned G = gridDim.x * gridDim.y * gridDim.z;
    unsigned sum, cnt, mine, sp = 0u;
    for (;;) {
        sum = 0u; cnt = 0u; mine = 0u;
#pragma unroll
        for (unsigned j = 0; j < 16; ++j) { const unsigned c = xb_ld(&bar[XB_XCNT(j)]); sum += c; cnt += (c > 0u) ? 1u : 0u; mine = (j == x) ? c : mine; }
        if (sum == G) break;
        __builtin_amdgcn_s_sleep(1);
        if ((++sp & 255u) == 0u) { if (xb_ld(&bar[XB_TMO])) break; if (sp > XB_SPIN_CAP) { atomicAdd(&bar[XB_TMO], 1u); break; } }
    }
    nloc = mine > 0u ? mine : 1u; nx = cnt > 0u ? cnt : 1u;
}

__device__ __forceinline__ void xcd_barrier(const XcdBarrier& b) {
    asm volatile("s_waitcnt vmcnt(0)" ::: "memory");
    __syncthreads();
    if (threadIdx.x == 0) {
        unsigned* bar = b.bar;
        __builtin_amdgcn_s_waitcnt(0);
        unsigned nloc = b.st[0], nx = b.st[1];
        if (nloc == 0u) { xcd_barrier_complete(bar, b.x, nloc, nx); b.st[0] = nloc; b.st[1] = nx; }
        const unsigned old = xb_add(&bar[XB_XSUB(b.x)], 1u);
        const unsigned gen = old / nloc;
        if (old + 1u == (gen + 1u) * nloc) {
            __builtin_amdgcn_fence(__ATOMIC_RELEASE, "agent");
            asm volatile("s_waitcnt vmcnt(0)" ::: "memory");
            const unsigned og = xb_add(&bar[XB_TOP], 1u);
            const unsigned tg = og / nx;
            if (og + 1u == (tg + 1u) * nx) xb_add(&bar[XB_TOPGEN], 1u);
            else XB_SPIN(xb_ld(&bar[XB_TOPGEN]) == tg, bar);
            __builtin_amdgcn_fence(__ATOMIC_ACQUIRE, "agent");
            xb_add(&bar[XB_XGEN(b.x)], 1u);
            asm volatile("s_waitcnt vmcnt(0)" ::: "memory");
        } else {
            XB_SPIN(xb_ld(&bar[XB_XGEN(b.x)]) == gen, bar);
            __builtin_amdgcn_fence(__ATOMIC_ACQUIRE, "agent");
            asm volatile("s_waitcnt vmcnt(0)" ::: "memory");
        }
    }
    __syncthreads();
}
#ifndef FFT_HD
#define FFT_HD __device__ __forceinline__
#define FFT_LDS __attribute__((address_space(3)))
#endif
#if defined(__clang__)
typedef float cpx __attribute__((ext_vector_type(2)));
#else
struct cpx { float x, y; };
#endif
#if defined(__HIP_DEVICE_COMPILE__)
FFT_HD float f_add(float a, float b) { float r; asm("v_add_f32_e32 %0, %1, %2" : "=v"(r) : "v"(a), "v"(b)); return r; }
FFT_HD float f_sub(float a, float b) { float r; asm("v_sub_f32_e32 %0, %1, %2" : "=v"(r) : "v"(a), "v"(b)); return r; }
FFT_HD float f_mul(float a, float b) { float r; asm("v_mul_f32_e32 %0, %1, %2" : "=v"(r) : "v"(a), "v"(b)); return r; }
FFT_HD float f_fma(float a, float b, float c) { float r; asm("v_fma_f32 %0, %1, %2, %3" : "=v"(r) : "v"(a), "v"(b), "v"(c)); return r; }
FFT_HD float f_fnma(float a, float b, float c) { float r; asm("v_fma_f32 %0, -%1, %2, %3" : "=v"(r) : "v"(a), "v"(b), "v"(c)); return r; }
#else
FFT_HD float f_add(float a, float b) { return a + b; }
FFT_HD float f_sub(float a, float b) { return a - b; }
FFT_HD float f_mul(float a, float b) { return a * b; }
FFT_HD float f_fma(float a, float b, float c) { return a * b + c; }
FFT_HD float f_fnma(float a, float b, float c) { return c - a * b; }
#endif
FFT_HD cpx c_add(cpx a, cpx b) { return cpx{f_add(a.x, b.x), f_add(a.y, b.y)}; }
FFT_HD cpx c_sub(cpx a, cpx b) { return cpx{f_sub(a.x, b.x), f_sub(a.y, b.y)}; }
FFT_HD cpx c_mul(cpx a, cpx b) { return cpx{f_fnma(a.y, b.y, f_mul(a.x, b.x)), f_fma(a.y, b.x, f_mul(a.x, b.y))}; }
constexpr int FFT_N = 16384, FFT_PHYS = FFT_N + (FFT_N >> 6) * 4;
FFT_HD int fft_p(int i) { return i + ((i >> 6) << 2); }

template <bool INV> FFT_HD void dft4(cpx& a0, cpx& a1, cpx& a2, cpx& a3) {
    const cpx s02 = c_add(a0, a2), d02 = c_sub(a0, a2), s13 = c_add(a1, a3), d13 = c_sub(a1, a3);
    a0 = c_add(s02, s13); a2 = c_sub(s02, s13);
    if (!INV) { a1 = cpx{f_add(d02.x, d13.y), f_sub(d02.y, d13.x)}; a3 = cpx{f_sub(d02.x, d13.y), f_add(d02.y, d13.x)}; }
    else      { a1 = cpx{f_sub(d02.x, d13.y), f_add(d02.y, d13.x)}; a3 = cpx{f_add(d02.x, d13.y), f_sub(d02.y, d13.x)}; }
}
FFT_HD cpx c_mulk(cpx a, float c, float s) { return cpx{f_fnma(a.y, s, f_mul(a.x, c)), f_fma(a.y, c, f_mul(a.x, s))}; }
template <bool INV> FFT_HD void dft16(cpx (&a)[16]) {
#pragma unroll
    for (int mb = 0; mb < 4; ++mb) dft4<INV>(a[mb], a[mb + 4], a[mb + 8], a[mb + 12]);
    const float C1 = 0.92387953251128674f, S1 = 0.38268343236508977f, R2 = 0.70710678118654752f;
    const float sg = INV ? 1.0f : -1.0f;
    a[5] = c_mulk(a[5], C1, sg * S1);
    a[6] = c_mulk(a[6], R2, sg * R2);
    a[7] = c_mulk(a[7], S1, sg * C1);
    a[9] = c_mulk(a[9], R2, sg * R2);
    a[10] = INV ? cpx{-a[10].y, a[10].x} : cpx{a[10].y, -a[10].x};
    a[11] = c_mulk(a[11], -R2, sg * R2);
    a[13] = c_mulk(a[13], S1, sg * C1);
    a[14] = c_mulk(a[14], -R2, sg * R2);
    a[15] = c_mulk(a[15], -C1, -sg * S1);
#pragma unroll
    for (int qa = 0; qa < 4; ++qa) dft4<INV>(a[4 * qa], a[4 * qa + 1], a[4 * qa + 2], a[4 * qa + 3]);
}
FFT_HD void fft_sincos(float frac, float& s, float& c) {
#if defined(__HIP_DEVICE_COMPILE__)
    s = __builtin_amdgcn_sinf(frac); c = __builtin_amdgcn_cosf(frac);
#else
    s = (float)sin(6.283185307179586 * (double)frac); c = (float)cos(6.283185307179586 * (double)frac);
#endif
}
template <bool INV, int S> FFT_HD void fft_pass16(FFT_LDS cpx* X, int b) {
    constexpr int n = 16 * S;
    constexpr int PS = (S >= 64) ? S + (S >> 4) : S;
    const int blk = b / S, j = b % S, base = blk * n + j;
    FFT_LDS cpx* xp = X + fft_p(base);
    cpx a[16];
    cpx w[16];
    { float sn, cs; fft_sincos((float)j / (float)n, sn, cs); w[1] = cpx{cs, INV ? sn : -sn};
      w[2] = c_mul(w[1], w[1]); w[3] = c_mul(w[2], w[1]); w[4] = c_mul(w[2], w[2]); w[5] = c_mul(w[4], w[1]); w[6] = c_mul(w[3], w[3]); w[7] = c_mul(w[4], w[3]);
      w[8] = c_mul(w[4], w[4]); w[9] = c_mul(w[8], w[1]); w[10] = c_mul(w[5], w[5]); w[11] = c_mul(w[8], w[3]); w[12] = c_mul(w[6], w[6]); w[13] = c_mul(w[8], w[5]);
      w[14] = c_mul(w[7], w[7]); w[15] = c_mul(w[8], w[7]); }
    if (!INV) {
#pragma unroll
        for (int m = 0; m < 16; ++m) a[m] = xp[PS * m];
        dft16<false>(a);
#pragma unroll
        for (int q = 0; q < 16; ++q) { cpx v = a[4 * (q & 3) + (q >> 2)]; if (q) v = c_mul(v, w[q]); xp[PS * q] = v; }
    } else {
#pragma unroll
        for (int q = 0; q < 16; ++q) { cpx v = xp[PS * q]; if (q) v = c_mul(v, w[q]); a[q] = v; }
        dft16<true>(a);
#pragma unroll
        for (int m = 0; m < 16; ++m) xp[PS * m] = a[4 * (m & 3) + (m >> 2)];
    }
}
template <bool INV> FFT_HD void fft_pass4(FFT_LDS cpx* X, int b) {
    const int p = fft_p(4 * b);
    cpx a0 = X[p], a1 = X[p + 1], a2 = X[p + 2], a3 = X[p + 3];
    dft4<INV>(a0, a1, a2, a3);
    X[p] = a0; X[p + 1] = a1; X[p + 2] = a2; X[p + 3] = a3;
}

typedef unsigned u32x2 __attribute__((ext_vector_type(2)));
struct Frame {
    LAS unsigned char* lds;
    volatile LAS unsigned* MISC;
    gu32* ctl;
    int tid, lane, wave;
    int vcu, G;
    const float *x, *norm1_g, *w_in, *sgu_norm_g, *sgu_w, *sgu_b, *hy_conv_w, *hy_conv_b;
    const float *f_w1, *f_b1, *f_w2, *f_b2, *f_w3, *f_b3, *f_freq, *f_wout, *d_skip;
    const float *on_a_g, *on_b_g, *w_out, *norm2_g, *w_up, *dw_w, *dw_b, *w_down, *final_g;
    float* out;
    float *ssv, *ssa, *ss2, *ss3, *h3, *hT, *dum_ss, *dum_out;
    bf16 *Wt_in, *Wt_out, *Wt_up, *Wt_dn, *xn1, *zu, *zvT, *binT, *ybT, *mrg, *hb, *xb2;
};
struct Args { const float* in[26]; float* out; unsigned char* ws; int ph_lo, ph_hi, li, pad; };
typedef const __attribute__((address_space(4))) Args* CArgsP;
__device__ __forceinline__ CArgsP kargs() {
    CArgsP p = (CArgsP)__builtin_amdgcn_kernarg_segment_ptr();
    asm volatile("" : "+s"(p));
    return p;
}
__device__ __forceinline__ void frame_ptrs(Frame& F) {
    extern __shared__ __attribute__((aligned(16))) unsigned char lds_dyn[];
    F.lds = (LAS unsigned char*)lds_dyn;
    F.MISC = (volatile LAS unsigned*)(F.lds + MISC_OFF);
    int tid_ = threadIdx.x; asm volatile("" : "+v"(tid_));
    F.tid = tid_; F.lane = F.tid & 63; F.wave = __builtin_amdgcn_readfirstlane(F.tid >> 6);
    int g_ = gridDim.x, bx_ = blockIdx.x; asm volatile("" : "+s"(g_), "+s"(bx_));
    F.G = g_; F.vcu = (F.G % 8 == 0) ? (bx_ % 8) * (F.G / 8) + bx_ / 8 : bx_;
    CArgsP A = kargs();
    unsigned char* ws = A->ws;
    F.ctl = (gu32*)(ws + WS_CTL);
    F.x = A->in[0]; F.norm1_g = A->in[1]; F.w_in = A->in[2]; F.sgu_norm_g = A->in[3]; F.sgu_w = A->in[4]; F.sgu_b = A->in[5];
    F.hy_conv_w = A->in[6]; F.hy_conv_b = A->in[7]; F.f_w1 = A->in[8]; F.f_b1 = A->in[9]; F.f_w2 = A->in[10]; F.f_b2 = A->in[11];
    F.f_w3 = A->in[12]; F.f_b3 = A->in[13]; F.f_freq = A->in[14]; F.f_wout = A->in[15]; F.d_skip = A->in[16];
    F.on_a_g = A->in[17]; F.on_b_g = A->in[18]; F.w_out = A->in[19]; F.norm2_g = A->in[20]; F.w_up = A->in[21];
    F.dw_w = A->in[22]; F.dw_b = A->in[23]; F.w_down = A->in[24]; F.final_g = A->in[25]; F.out = A->out;
    F.ssv = (float*)(ws + WS_SS); F.ssa = F.ssv + M; F.ss2 = F.ssa + M; F.ss3 = F.ss2 + M;
    F.h3 = (float*)(ws + WS_H3); F.hT = (float*)(ws + WS_HT); F.dum_ss = F.ssv + 4 * M; F.dum_out = (float*)(ws + WS_DUMOUT);
    F.Wt_in = (bf16*)(ws + WS_WIN); F.Wt_out = (bf16*)(ws + WS_WOUT); F.Wt_up = (bf16*)(ws + WS_WUP); F.Wt_dn = (bf16*)(ws + WS_WDN);
    F.xn1 = (bf16*)(ws + WS_XN1); F.zu = (bf16*)(ws + WS_ZU); F.zvT = (bf16*)(ws + WS_ZVT); F.binT = (bf16*)(ws + WS_BINT);
    F.ybT = (bf16*)(ws + WS_YBT); F.mrg = (bf16*)(ws + WS_MRG); F.hb = (bf16*)(ws + WS_H); F.xb2 = (bf16*)(ws + WS_XB2);
}


__device__ __forceinline__ float wave_sum(float v) {
#pragma unroll
    for (int o = 1; o < 64; o <<= 1) v += __shfl_xor(v, o);
    return v;
}
__device__ __forceinline__ float bf2f(unsigned short b) { return __builtin_bit_cast(float, ((unsigned)b) << 16); }
__device__ __forceinline__ float bflo(unsigned w) { return __builtin_bit_cast(float, w << 16); }
__device__ __forceinline__ float bfhi(unsigned w) { return __builtin_bit_cast(float, w & 0xffff0000u); }
__device__ __forceinline__ float gelu_f(float v) { return 0.5f * v * (1.0f + erff(v * 0.70710678118654752f)); }
__device__ __forceinline__ float rsq(float v) { return 1.0f / sqrtf(v); }

namespace pg8 {
struct Epi1b {
    static constexpr bool PERM = true, AFTER_DRAIN = false;
    bf16_t* zvT; bf16_t* binT; const float* g_sgu; float* ssv;
    __device__ __forceinline__ void operator()(const f32x4 (&acc)[2][2][4][2], const Unit& u, int wr, int wc, int fr, int fq) const {
        const int row0 = u.pm * BM + wr * 64 + fr, col0 = u.pn * BM + wc * 32 + 8 * fq;
        if (u.pm < 4) {
            float ss[2][8];
#pragma unroll
            for (int bj = 0; bj < 2; ++bj)
#pragma unroll
                for (int k = 0; k < 8; ++k) ss[bj][k] = 0.f;
#pragma unroll
            for (int ai = 0; ai < 2; ++ai)
#pragma unroll
                for (int m = 0; m < 4; ++m) { const int r = row0 + ai * HALF + m * 16; const float gg = g_sgu[r]; bf16_t* rowp = zvT + (size_t)r * 16384 + col0;
#pragma unroll
                    for (int bj = 0; bj < 2; ++bj) { const f32x4 v0 = acc[ai][bj][m][0], v1 = acc[ai][bj][m][1];
                        const f32x2 a = gelu_pk((f32x2){v0[0], v0[1]}), b = gelu_pk((f32x2){v0[2], v0[3]}), c = gelu_pk((f32x2){v1[0], v1[1]}), d = gelu_pk((f32x2){v1[2], v1[3]});
                        ss[bj][0] += a.x * a.x; ss[bj][1] += a.y * a.y; ss[bj][2] += b.x * b.x; ss[bj][3] += b.y * b.y;
                        ss[bj][4] += c.x * c.x; ss[bj][5] += c.y * c.y; ss[bj][6] += d.x * d.x; ss[bj][7] += d.y * d.y;
                        u32x4 w; w.x = cvt_pk_bf16(a.x * gg, a.y * gg); w.y = cvt_pk_bf16(b.x * gg, b.y * gg); w.z = cvt_pk_bf16(c.x * gg, c.y * gg); w.w = cvt_pk_bf16(d.x * gg, d.y * gg);
                        *(u32x4*)(rowp + bj * HALF) = w; } }
#pragma unroll
            for (int bj = 0; bj < 2; ++bj)
#pragma unroll
                for (int k = 0; k < 8; ++k) { float v = ss[bj][k]; v += __shfl_xor(v, 1); v += __shfl_xor(v, 2); v += __shfl_xor(v, 4); v += __shfl_xor(v, 8);
                    if (fr == 0) atomicAdd(ssv + col0 + bj * HALF + k, v); }
        } else {
#pragma unroll
            for (int ai = 0; ai < 2; ++ai)
#pragma unroll
                for (int m = 0; m < 4; ++m) { const int r = row0 + ai * HALF + m * 16 - 1024; bf16_t* rowp = binT + (size_t)r * 16384 + col0;
#pragma unroll
                    for (int bj = 0; bj < 2; ++bj) { const f32x4 v0 = acc[ai][bj][m][0], v1 = acc[ai][bj][m][1];
                        u32x4 w; w.x = cvt_pk_bf16(v0[0], v0[1]); w.y = cvt_pk_bf16(v0[2], v0[3]); w.z = cvt_pk_bf16(v1[0], v1[1]); w.w = cvt_pk_bf16(v1[2], v1[3]);
                        *(u32x4*)(rowp + bj * HALF) = w; } }
        }
    }
};
struct Epi2 {
    static constexpr bool PERM = true, AFTER_DRAIN = false;
    const float* x; float* x1; bf16_t* xb2; const float* ssa; float* ss2;
    __device__ __forceinline__ void operator()(const f32x4 (&acc)[2][2][4][2], const Unit& u, int wr, int wc, int fr, int fq) const {
        const int row0 = u.pm * BM + wr * 64 + fr, col0 = u.pn * BM + wc * 32 + 8 * fq;
#pragma unroll
        for (int ai = 0; ai < 2; ++ai)
#pragma unroll
            for (int m = 0; m < 4; ++m) { const int r = row0 + ai * HALF + m * 16; const float ra = 1.0f / sqrtf(ssa[r] * (1.0f / 1024.0f) + 1e-6f); float s = 0.f;
                const size_t off = (size_t)r * 2048 + col0;
#pragma unroll
                for (int bj = 0; bj < 2; ++bj) { const f32x4 x0 = *(const f32x4*)(x + off + bj * HALF), x4 = *(const f32x4*)(x + off + bj * HALF + 4);
                    const f32x4 v0 = x0 + acc[ai][bj][m][0] * ra, v1 = x4 + acc[ai][bj][m][1] * ra;
                    *(f32x4*)(x1 + off + bj * HALF) = v0; *(f32x4*)(x1 + off + bj * HALF + 4) = v1;
                    s += (v0[0] * v0[0] + v0[1] * v0[1]) + (v0[2] * v0[2] + v0[3] * v0[3]) + (v1[0] * v1[0] + v1[1] * v1[1]) + (v1[2] * v1[2] + v1[3] * v1[3]);
                    u32x4 w; w.x = cvt_pk_bf16(v0[0], v0[1]); w.y = cvt_pk_bf16(v0[2], v0[3]); w.z = cvt_pk_bf16(v1[0], v1[1]); w.w = cvt_pk_bf16(v1[2], v1[3]);
                    *(u32x4*)(xb2 + off + bj * HALF) = w; }
                s += __shfl_xor(s, 16); s += __shfl_xor(s, 32);
                if (fq == 0) atomicAdd(ss2 + r, s);
                asm volatile("" ::: "memory"); }
    }
};
struct Epi3 {
    static constexpr bool PERM = true, AFTER_DRAIN = false;
    bf16_t* h; const float* ss2; const float* dw_w; const float* dw_b; PG8_LAS float* E;
    __device__ __forceinline__ void operator()(const f32x4 (&acc)[2][2][4][2], const Unit& u, int wr, int wc, int fr, int fq) const {
        const int lane = fq * 16 + fr, lprev = (lane & 48) | ((lane - 1) & 15), lnext = (lane & 48) | ((lane + 1) & 15);
        const int chl = wc * 32 + 8 * fq, ch = u.pn * 128 + chl, rowbase = u.pm * 254 - 1;
        float r2[2][4];
#pragma unroll
        for (int ai = 0; ai < 2; ++ai)
#pragma unroll
            for (int m = 0; m < 4; ++m) { const int tg = rowbase + ai * HALF + wr * 64 + m * 16 + fr; r2[ai][m] = (tg >= 0 && tg < 16384) ? 1.0f / sqrtf(ss2[tg] * (1.0f / 2048.0f) + 1e-6f) : 0.f; }
#pragma unroll
        for (int ai = 0; ai < 2; ++ai) { const int kb = 2 * ai + wr;
            if (fr == 0) { *(PG8_LAS f32x4*)(E + kb * 128 + chl) = acc[ai][0][0][0] * r2[ai][0]; *(PG8_LAS f32x4*)(E + kb * 128 + chl + 4) = acc[ai][0][0][1] * r2[ai][0]; }
            if (fr == 15) { *(PG8_LAS f32x4*)(E + 512 + kb * 128 + chl) = acc[ai][0][3][0] * r2[ai][3]; *(PG8_LAS f32x4*)(E + 512 + kb * 128 + chl + 4) = acc[ai][0][3][1] * r2[ai][3]; } }
        asm volatile("s_waitcnt lgkmcnt(0)" ::: "memory"); __builtin_amdgcn_s_barrier(); asm volatile("" ::: "memory");
#pragma unroll
        for (int ai = 0; ai < 2; ++ai) { const int kb = 2 * ai + wr;
            unsigned pk[4][4];
            bool pz[4], nz[4];
#pragma unroll
            for (int m = 0; m < 4; ++m) { const int tg = rowbase + ai * HALF + wr * 64 + m * 16 + fr; pz[m] = (tg & 8191) == 0; nz[m] = (tg & 8191) == 8191; }
#pragma unroll
            for (int n = 0; n < 2; ++n)
#pragma unroll
                for (int jp = 0; jp < 2; ++jp) { const int c0 = 4 * n + 2 * jp;
                    const f32x2 w0 = *(const f32x2*)(dw_w + ch + c0), w1 = *(const f32x2*)(dw_w + 5504 + ch + c0), w2 = *(const f32x2*)(dw_w + 11008 + ch + c0), bb = *(const f32x2*)(dw_b + ch + c0);
                    f32x2 pe = (f32x2){0.f, 0.f}, ne = (f32x2){0.f, 0.f};
                    if (kb >= 1) pe = *(const PG8_LAS f32x2*)(E + 512 + (kb - 1) * 128 + chl + c0);
                    if (kb <= 2) ne = *(const PG8_LAS f32x2*)(E + (kb + 1) * 128 + chl + c0);
                    float oo[4][2];
#pragma unroll
                    for (int jj = 0; jj < 2; ++jj) { const int j = 2 * jp + jj;
                        float g[4], R[4], L[4];
#pragma unroll
                        for (int m = 0; m < 4; ++m) { g[m] = acc[ai][0][m][n][j] * r2[ai][m]; R[m] = __shfl(g[m], lprev); L[m] = __shfl(g[m], lnext); }
#pragma unroll
                        for (int m = 0; m < 4; ++m) { float gp = (fr == 0) ? ((m == 0) ? pe[jj] : R[(m + 3) & 3]) : R[m]; float gn = (fr == 15) ? ((m == 3) ? ne[jj] : L[(m + 1) & 3]) : L[m];
                            if (pz[m]) gp = 0.f; if (nz[m]) gn = 0.f;
                            oo[m][jj] = w0[jj] * gp + w1[jj] * g[m] + w2[jj] * gn + bb[jj]; } }
#pragma unroll
                    for (int m = 0; m < 4; ++m) { const f32x2 ge = gelu_pk((f32x2){oo[m][0], oo[m][1]});
                        pk[m][2 * n + jp] = cvt_pk_bf16(ge.x * acc[ai][1][m][n][2 * jp] * r2[ai][m], ge.y * acc[ai][1][m][n][2 * jp + 1] * r2[ai][m]); } }
#pragma unroll
            for (int m = 0; m < 4; ++m) { const int rl = ai * HALF + wr * 64 + m * 16 + fr, tg = rowbase + rl;
                u32x4 w; w.x = pk[m][0]; w.y = pk[m][1]; w.z = pk[m][2]; w.w = pk[m][3];
                if (rl >= 1 && rl <= 254 && tg < 16384) *(u32x4*)(h + (size_t)tg * 5504 + ch) = w; } }
    }
};
struct Epi4 {
    static constexpr bool PERM = true, AFTER_DRAIN = false;
    const float* x1; float* xo; float* ss3;
    __device__ __forceinline__ void operator()(const f32x4 (&acc)[2][2][4][2], const Unit& u, int wr, int wc, int fr, int fq) const {
        const int row0 = u.pm * BM + wr * 64 + fr, col0 = u.pn * BM + wc * 32 + 8 * fq;
#pragma unroll
        for (int ai = 0; ai < 2; ++ai)
#pragma unroll
            for (int m = 0; m < 4; ++m) { const int r = row0 + ai * HALF + m * 16; float s = 0.f; const size_t off = (size_t)r * 2048 + col0;
#pragma unroll
                for (int bj = 0; bj < 2; ++bj) { const f32x4 x0 = *(const f32x4*)(x1 + off + bj * HALF), x4 = *(const f32x4*)(x1 + off + bj * HALF + 4);
                    const f32x4 v0 = x0 + acc[ai][bj][m][0], v1 = x4 + acc[ai][bj][m][1];
                    *(f32x4*)(xo + off + bj * HALF) = v0; *(f32x4*)(xo + off + bj * HALF + 4) = v1;
                    s += (v0[0] * v0[0] + v0[1] * v0[1]) + (v0[2] * v0[2] + v0[3] * v0[3]) + (v1[0] * v1[0] + v1[1] * v1[1]) + (v1[2] * v1[2] + v1[3] * v1[3]); }
                s += __shfl_xor(s, 16); s += __shfl_xor(s, 32);
                if (fq == 0) atomicAdd(ss3 + r, s);
                asm volatile("" ::: "memory"); }
    }
};
}

template <int MODE  , bool SCALED>
__device__ __forceinline__ void p0_transpose_item(const float* W, int K, int N, bf16* WT, const float* kscale, LAS float* scr, int item, int lane) {
    const int nblk = N / 32, kb = item / nblk, nb = item % nblk, k0 = 64 * kb, n0 = 32 * nb;
    float v[32];
#pragma unroll
    for (int i = 0; i < 32; ++i) v[i] = W[(size_t)(k0 + 2 * i + (lane >> 5)) * N + n0 + (lane & 31)];
    if (SCALED) {
#pragma unroll
        for (int i = 0; i < 32; ++i) v[i] *= kscale[k0 + 2 * i + (lane >> 5)]; }
#pragma unroll
    for (int i = 0; i < 32; ++i) scr[(2 * i + (lane >> 5)) * 33 + (lane & 31)] = v[i];
    LDS_WAIT(); asm volatile("" ::: "memory");
    const int c = lane & 7;
    int r0 = n0;
    if (MODE == 1) { const int half = n0 / DFF, rem = n0 % DFF, tile = rem / 128, j = rem % 128; r0 = tile * 256 + half * 128 + j; }
#pragma unroll
    for (int j = 0; j < 4; ++j) { const int n = (lane >> 3) + 8 * j; const LAS float* s = scr + (8 * c) * 33 + n;
        v4u o; o.x = pk2(s[0 * 33], s[1 * 33]); o.y = pk2(s[2 * 33], s[3 * 33]); o.z = pk2(s[4 * 33], s[5 * 33]); o.w = pk2(s[6 * 33], s[7 * 33]);
        *(GAS v4u*)(WT + (size_t)(r0 + n) * K + k0 + 8 * c) = o; }
    LDS_WAIT(); asm volatile("" ::: "memory");
}

__device__ __forceinline__ void p0_prologue(Frame& F) {
    LAS float* scr = (LAS float*)(F.lds + RING_OFF + F.wave * 16384);
    const int gw = F.vcu * NWAVES + F.wave, NGW = F.G * NWAVES;
    const int lane = F.lane;
    for (int i = gw * 64 + lane; i < 4 * M; i += NGW * 64) F.ssv[i] = 0.f;
    constexpr int I_IN = (DM / 64) * (DIN / 32), I_OUT = (DM / 64) * (DM / 32), I_UP = (DM / 64) * (NUP / 32), I_DN = (DFF / 64) * (DM / 32);
    constexpr int NITEMS = I_IN + I_OUT + I_UP + I_DN;
    for (int it = gw; it < NITEMS; it += NGW) {
        int r = it;
        if (r < I_IN) { p0_transpose_item<0, false>(F.w_in, DM, DIN, F.Wt_in, nullptr, scr, r, lane); continue; } r -= I_IN;
        if (r < I_OUT) { const int kb = r / (DM / 32); p0_transpose_item<0, true>(F.w_out, DM, DM, F.Wt_out, (kb < 16) ? F.on_a_g : (F.on_b_g - 1024), scr, r, lane); continue; } r -= I_OUT;
        if (r < I_UP) { p0_transpose_item<1, true>(F.w_up, DM, NUP, F.Wt_up, F.norm2_g, scr, r, lane); continue; } r -= I_UP;
        p0_transpose_item<0, false>(F.w_down, DFF, DM, F.Wt_dn, nullptr, scr, r, lane);
    }
    for (int m = gw; m < M; m += NGW) {
        const GAS f32x4* xr = (const GAS f32x4*)(F.x + (size_t)m * DM) + lane;
        f32x4 v[8]; float s = 0.f;
#pragma unroll
        for (int j = 0; j < 8; ++j) { v[j] = xr[64 * j]; s += (v[j].x * v[j].x + v[j].y * v[j].y) + (v[j].z * v[j].z + v[j].w * v[j].w); }
        const float r = rsq(wave_sum(s) * (1.0f / DM) + EPS);
        GAS unsigned long long* o8 = (GAS unsigned long long*)(F.xn1 + (size_t)m * DM) + lane;
#pragma unroll
        for (int j = 0; j < 8; ++j) { const f32x4 g = ((const GAS f32x4*)F.norm1_g)[lane + 64 * j]; const f32x4 o = v[j] * r * g;
            o8[64 * j] = (unsigned long long)pk2(o.x, o.y) | ((unsigned long long)pk2(o.z, o.w) << 32); }
    }
    for (int t = gw; t < SEQ; t += NGW) {
        float z = 0.f;
        { const float tl = (float)t / (float)(SEQ - 1); const float w = (6.283185307179586f / (float)SEQ) * (float)t;
          if (lane == 0) z = tl;
          else if (lane <= 16) { const float f = 1e-4f + (float)(lane - 1) * ((15.0f - 1e-4f) / 15.0f); z = cosf(f * w); }
          else if (lane <= 32) { const float f = 1e-4f + (float)(lane - 17) * ((15.0f - 1e-4f) / 15.0f); z = -sinf(f * w); } }
        const float fr = F.f_freq[lane];
        float a = F.f_b1[lane];
        for (int k = 0; k < 33; ++k) a += __shfl(z, k) * F.f_w1[k * 64 + lane];
        float h = sinf(fr * a);
        a = F.f_b2[lane];
        for (int k = 0; k < 64; ++k) a += __shfl(h, k) * F.f_w2[k * 64 + lane];
        h = sinf(fr * a);
        a = F.f_b3[lane];
        for (int k = 0; k < 64; ++k) a += __shfl(h, k) * F.f_w3[k * 64 + lane];
        h = sinf(fr * a);
        F.h3[(size_t)t * 64 + lane] = h;
    }
}

__device__ __forceinline__ void sgu_unit(Frame& F, int unit, float* ssa_dst) {
    const int h = unit & 7, pos0 = (unit >> 3) * 128;
    LAS unsigned char* As = F.lds; LAS unsigned char* Bs = F.lds + 128 * 272;
    const int t = F.tid, lane = F.lane, w = F.wave;
    {
        const int i = t >> 2, j0 = (t & 3) * 32;
        const GAS f32x4* wrow = (const GAS f32x4*)(F.sgu_w + ((size_t)h * 128 + i) * 128 + j0);
        const GAS f32x4* ssp = (const GAS f32x4*)(F.ssv + pos0 + j0);
#pragma unroll
        for (int q = 0; q < 4; ++q) { const f32x4 w0 = wrow[2 * q], w1 = wrow[2 * q + 1], s0 = ssp[2 * q], s1 = ssp[2 * q + 1];
            v4u o; o.x = pk2(w0.x * rsq(s0.x * (1.f / 1024.f) + EPS), w0.y * rsq(s0.y * (1.f / 1024.f) + EPS)); o.y = pk2(w0.z * rsq(s0.z * (1.f / 1024.f) + EPS), w0.w * rsq(s0.w * (1.f / 1024.f) + EPS));
            o.z = pk2(w1.x * rsq(s1.x * (1.f / 1024.f) + EPS), w1.y * rsq(s1.y * (1.f / 1024.f) + EPS)); o.w = pk2(w1.z * rsq(s1.z * (1.f / 1024.f) + EPS), w1.w * rsq(s1.w * (1.f / 1024.f) + EPS));
            *(LAS v4u*)(As + i * 272 + (j0 + 8 * q) * 2) = o; }
    }
    {
        const int d = t >> 2, c0 = (t & 3) * 32;
        const GAS v4u* src = (const GAS v4u*)(F.zvT + (size_t)(h * 128 + d) * M + pos0 + c0);
#pragma unroll
        for (int q = 0; q < 4; ++q) *(LAS v4u*)(Bs + d * 272 + (c0 + 8 * q) * 2) = src[q];
    }
    __syncthreads();
    const int iw = w & 3, dw = w >> 2, r = lane & 15, q = lane >> 4;
    f32x4 acc[2][4];
#pragma unroll
    for (int it = 0; it < 2; ++it)
#pragma unroll
        for (int dt = 0; dt < 4; ++dt) acc[it][dt] = (f32x4){0.f, 0.f, 0.f, 0.f};
#pragma unroll
    for (int ks = 0; ks < 4; ++ks) {
        bf16x8 a[2], b[4];
#pragma unroll
        for (int it = 0; it < 2; ++it) a[it] = *(const LAS bf16x8*)(As + (32 * iw + 16 * it + r) * 272 + (32 * ks + 8 * q) * 2);
#pragma unroll
        for (int dt = 0; dt < 4; ++dt) b[dt] = *(const LAS bf16x8*)(Bs + (64 * dw + 16 * dt + r) * 272 + (32 * ks + 8 * q) * 2);
#pragma unroll
        for (int it = 0; it < 2; ++it)
#pragma unroll
            for (int dt = 0; dt < 4; ++dt) acc[it][dt] = __builtin_amdgcn_mfma_f32_16x16x32_bf16(b[dt], a[it], acc[it][dt], 0, 0, 0);
    }
#pragma unroll
    for (int it = 0; it < 2; ++it) { const int i = 32 * iw + 16 * it + r, row = pos0 + i; const float bias = F.sgu_b[h * 128 + i]; float ss = 0.f;
#pragma unroll
        for (int dt = 0; dt < 4; ++dt) { const int col = h * 128 + 64 * dw + 16 * dt + 4 * q;
            const u32x2 zz = *(const GAS u32x2*)(F.zu + (size_t)row * DA + col);
            const float y0 = bflo(zz.x) * (acc[it][dt][0] + bias), y1 = bfhi(zz.x) * (acc[it][dt][1] + bias), y2 = bflo(zz.y) * (acc[it][dt][2] + bias), y3 = bfhi(zz.y) * (acc[it][dt][3] + bias);
            ss += (y0 * y0 + y1 * y1) + (y2 * y2 + y3 * y3);
            u32x2 o; o.x = pk2(y0, y1); o.y = pk2(y2, y3);
            *(GAS u32x2*)(F.mrg + (size_t)row * DM + col) = o; }
        ss += __shfl_xor(ss, 16); ss += __shfl_xor(ss, 32);
        if (q == 0) atomicAdd(ssa_dst + row, ss); }
    __syncthreads();
}

typedef float f32x16 __attribute__((ext_vector_type(16)));
__device__ __forceinline__ void p1_filter_gemm(Frame& F) {
    const int gw = F.vcu * NWAVES + F.wave, NGW = F.G * NWAVES, lane = F.lane, i = lane & 31, hh = lane >> 5;
    for (int tile = gw; tile < 64 * 256; tile += NGW) { const int ct = tile >> 8, tt = tile & 255;
        f32x16 acc;
#pragma unroll
        for (int r = 0; r < 16; ++r) acc[r] = 0.f;
        const GAS f32x4* hrow = (const GAS f32x4*)(F.h3 + (size_t)(tt * 32 + i) * 64 + 32 * hh);
        const GAS float* wcol = (const GAS float*)F.f_wout + (size_t)(32 * hh) * 2048 + ct * 32 + i;
#pragma unroll
        for (int k4 = 0; k4 < 8; ++k4) { const f32x4 hv = hrow[k4];
            acc = __builtin_amdgcn_mfma_f32_32x32x2f32(wcol[(size_t)(4 * k4 + 0) * 2048], hv.x, acc, 0, 0, 0);
            acc = __builtin_amdgcn_mfma_f32_32x32x2f32(wcol[(size_t)(4 * k4 + 1) * 2048], hv.y, acc, 0, 0, 0);
            acc = __builtin_amdgcn_mfma_f32_32x32x2f32(wcol[(size_t)(4 * k4 + 2) * 2048], hv.z, acc, 0, 0, 0);
            acc = __builtin_amdgcn_mfma_f32_32x32x2f32(wcol[(size_t)(4 * k4 + 3) * 2048], hv.w, acc, 0, 0, 0); }
#pragma unroll
        for (int r = 0; r < 16; ++r) { const int row = (r & 3) + 8 * (r >> 2) + 4 * hh; F.hT[(size_t)(ct * 32 + row) * SEQ + tt * 32 + i] = acc[r]; }
    }
}

struct Raw8 { v4u v; unsigned hm, hp; };
__device__ __forceinline__ Raw8 raw8_load(const bf16* p, int pos0) {
    Raw8 r; r.v = *(const GAS v4u*)(p + pos0); r.hm = p[pos0 > 0 ? pos0 - 1 : 0]; r.hp = p[pos0 + 8 < M ? pos0 + 8 : M - 1]; return r;
}
__device__ __forceinline__ void dwc3x8(const Raw8& r, int t0, float w0, float w1, float w2, float b, float (&o)[8]) {
    float x[10];
    x[0] = (t0 > 0) ? bf2f((unsigned short)r.hm) : 0.f; x[9] = (t0 + 8 < SEQ) ? bf2f((unsigned short)r.hp) : 0.f;
    x[1] = bflo(r.v.x); x[2] = bfhi(r.v.x); x[3] = bflo(r.v.y); x[4] = bfhi(r.v.y); x[5] = bflo(r.v.z); x[6] = bfhi(r.v.z); x[7] = bflo(r.v.w); x[8] = bfhi(r.v.w);
#pragma unroll
    for (int k = 0; k < 8; ++k) o[k] = x[k] * w0 + x[k + 1] * w1 + x[k + 2] * w2 + b;
}
__device__ __forceinline__ void fft_fwd_all(LAS cpx* X, int tid) {
    int nb = 2; asm volatile("" : "+s"(nb));
#pragma unroll 1
    for (int i = 0; i < nb; ++i) fft_pass16<false, 1024>(X, tid + 512 * i);
    __syncthreads();
#pragma unroll 1
    for (int i = 0; i < nb; ++i) fft_pass16<false, 64>(X, tid + 512 * i);
    __syncthreads();
#pragma unroll 1
    for (int i = 0; i < nb; ++i) fft_pass16<false, 4>(X, tid + 512 * i);
    __syncthreads();
#pragma unroll 2
    for (int i = 0; i < 8; ++i) fft_pass4<false>(X, tid + 512 * i);
    __syncthreads();
}
__device__ __forceinline__ void fft_inv_all(LAS cpx* X, int tid) {
    int nb = 2; asm volatile("" : "+s"(nb));
#pragma unroll 2
    for (int i = 0; i < 8; ++i) fft_pass4<true>(X, tid + 512 * i);
    __syncthreads();
#pragma unroll 1
    for (int i = 0; i < nb; ++i) fft_pass16<true, 4>(X, tid + 512 * i);
    __syncthreads();
#pragma unroll 1
    for (int i = 0; i < nb; ++i) fft_pass16<true, 64>(X, tid + 512 * i);
    __syncthreads();
#pragma unroll 1
    for (int i = 0; i < nb; ++i) fft_pass16<true, 1024>(X, tid + 512 * i);
    __syncthreads();
}
__device__ __forceinline__ void hyena_phase(Frame& F) {
    LAS cpx* X = (LAS cpx*)F.lds; LAS float* red = (LAS float*)(F.lds + RED_OFF);
    const int tid = F.tid;
    const float min_decay = logf(1e-2f) / 1.5f, max_decay = logf(1e-2f) / 0.3f;
    int c = F.vcu;
#pragma unroll 1
    for (; c < DB; c += F.G) {
        const float delta = fabsf(min_decay + (float)c * ((max_decay - min_decay) / 1023.0f));
        const bf16* p0 = F.binT + (size_t)c * M; const bf16* p1 = F.binT + (size_t)(1024 + c) * M; const bf16* p2 = F.binT + (size_t)(2048 + c) * M;
        {
            float l1 = 0.f;
            const float* hf = F.hT + (size_t)c * SEQ; const float* hb = F.hT + (size_t)(1024 + c) * SEQ;
#pragma unroll 1
            for (int i0 = 0; i0 < 16; i0 += 8) { float vf[8], vb[8];
#pragma unroll
                for (int i = 0; i < 8; ++i) { vf[i] = hf[tid + 512 * (i0 + i)]; vb[i] = hb[tid + 512 * (i0 + i)]; }
#pragma unroll
                for (int i = 0; i < 8; ++i) { const int d = tid + 512 * (i0 + i); const float win = __expf(-((float)d * (1.0f / (float)(SEQ - 1))) * delta);
                    const float kf = vf[i] * win, kb = vb[i] * win;
                    X[fft_p(d)] = cpx{kf, 0.f}; l1 += fabsf(kf);
                    if (d >= 1) { X[fft_p(FFT_N - d)] = cpx{kb, 0.f}; l1 += fabsf(kb); } else X[fft_p(SEQ)] = cpx{0.f, 0.f}; } }
            l1 = wave_sum(l1);
            if (F.lane == 0) red[F.wave] = l1;
        }
        asm volatile("" ::: "memory");
        Raw8 r1a[2], r2a[2], r1b[2], r2b[2];
#pragma unroll
        for (int i = 0; i < 2; ++i) { const int t0 = 8 * (tid + 512 * i); r1a[i] = raw8_load(p1, t0); r2a[i] = raw8_load(p2, t0); r1b[i] = raw8_load(p1, SEQ + t0); r2b[i] = raw8_load(p2, SEQ + t0); }
        __syncthreads();
        float tot = 0.f;
#pragma unroll
        for (int i = 0; i < NWAVES; ++i) tot += red[i];
        const float scale = 1.0f / (tot + EPS);
        const float dsk = F.d_skip[c];
        fft_fwd_all(X, tid);
        typedef _Float16 h16x4 __attribute__((ext_vector_type(4)));
        h16x4 kreg[17];
        {
            const LAS f32x4* src = (const LAS f32x4*)X;
#pragma unroll
            for (int i = 0; i < 17; ++i) kreg[i] = __builtin_convertvector(src[tid + 512 * i] * scale, h16x4);
        }
        __syncthreads();
        {
            const float w10 = F.hy_conv_w[1024 + c], w11 = F.hy_conv_w[3072 + 1024 + c], w12 = F.hy_conv_w[6144 + 1024 + c], b1 = F.hy_conv_b[1024 + c];
            const float w20 = F.hy_conv_w[2048 + c], w21 = F.hy_conv_w[3072 + 2048 + c], w22 = F.hy_conv_w[6144 + 2048 + c], b2 = F.hy_conv_b[2048 + c];
#pragma unroll
            for (int i = 0; i < 2; ++i) { const int t0 = 8 * (tid + 512 * i);
                float a1[8], a2[8], c1[8], c2[8];
                dwc3x8(r1a[i], t0, w10, w11, w12, b1, a1); dwc3x8(r2a[i], t0, w20, w21, w22, b2, a2);
                dwc3x8(r1b[i], t0, w10, w11, w12, b1, c1); dwc3x8(r2b[i], t0, w20, w21, w22, b2, c2);
                LAS f32x4* dst = (LAS f32x4*)(X + fft_p(t0)); LAS f32x4* dz = (LAS f32x4*)(X + fft_p(SEQ + t0));
#pragma unroll
                for (int k = 0; k < 4; ++k) { dst[k] = (f32x4){a1[2 * k] * a2[2 * k], c1[2 * k] * c2[2 * k], a1[2 * k + 1] * a2[2 * k + 1], c1[2 * k + 1] * c2[2 * k + 1]}; dz[k] = (f32x4){0.f, 0.f, 0.f, 0.f}; } }
        }
        asm volatile("" ::: "memory");
        Raw8 r0a[2], r0b[2];
#pragma unroll
        for (int i = 0; i < 2; ++i) { const int t0 = 8 * (tid + 512 * i); r0a[i] = raw8_load(p0, t0); r0b[i] = raw8_load(p0, SEQ + t0); }
        __syncthreads();
#ifdef PROBE_FFT
        fft_fwd_all(X, tid); fft_inv_all(X, tid);
        { LAS f32x4* xx = (LAS f32x4*)X;
#pragma unroll 4
          for (int i = 0; i < 17; ++i) xx[tid + 512 * i] = xx[tid + 512 * i] * (1.0f / (float)FFT_N); }
        __syncthreads();
#endif
        fft_fwd_all(X, tid);
        {
            LAS f32x4* xx = (LAS f32x4*)X;
            const float invn = 1.0f / (float)FFT_N;
#pragma unroll
            for (int i = 0; i < 17; ++i) { const f32x4 a = xx[tid + 512 * i]; f32x4 k = __builtin_convertvector(kreg[i], f32x4); k.x += dsk; k.z += dsk;
                xx[tid + 512 * i] = (f32x4){(a.x * k.x - a.y * k.y) * invn, (a.x * k.y + a.y * k.x) * invn, (a.z * k.z - a.w * k.w) * invn, (a.z * k.w + a.w * k.z) * invn}; }
        }
        __syncthreads();
        fft_inv_all(X, tid);
        {
            const float w00 = F.hy_conv_w[c], w01 = F.hy_conv_w[3072 + c], w02 = F.hy_conv_w[6144 + c], b0 = F.hy_conv_b[c];
#pragma unroll
            for (int i = 0; i < 2; ++i) { const int t0 = 8 * (tid + 512 * i);
                float xa[8], xb[8];
                dwc3x8(r0a[i], t0, w00, w01, w02, b0, xa); dwc3x8(r0b[i], t0, w00, w01, w02, b0, xb);
                const LAS f32x4* src = (const LAS f32x4*)(X + fft_p(t0));
                const f32x4 y0 = src[0], y1 = src[1], y2 = src[2], y3 = src[3];
                v4u oa, ob;
                oa.x = pk2(xa[0] * y0.x, xa[1] * y0.z); oa.y = pk2(xa[2] * y1.x, xa[3] * y1.z); oa.z = pk2(xa[4] * y2.x, xa[5] * y2.z); oa.w = pk2(xa[6] * y3.x, xa[7] * y3.z);
                ob.x = pk2(xb[0] * y0.y, xb[1] * y0.w); ob.y = pk2(xb[2] * y1.y, xb[3] * y1.w); ob.z = pk2(xb[4] * y2.y, xb[5] * y2.w); ob.w = pk2(xb[6] * y3.y, xb[7] * y3.w);
                *(GAS v4u*)(F.ybT + (size_t)c * M + t0) = oa; *(GAS v4u*)(F.ybT + (size_t)c * M + SEQ + t0) = ob; }
        }
        __syncthreads();
    }
}

__device__ __forceinline__ void p3_merge(Frame& F) {
    for (int i = F.vcu * 512 + F.tid; i < 129 * (DM / 8); i += F.G * 512) { const int r = i / (DM / 8), q = i % (DM / 8); const int row = (r == 128) ? -1 : M + r;
        *(GAS v4u*)(F.xb2 + (ptrdiff_t)row * DM + q * 8) = (v4u){0u, 0u, 0u, 0u}; }
    LAS unsigned char* T = F.lds;
    const int tid = F.tid, lane = F.lane, w = F.wave;
    for (int tile = F.vcu; tile < M / 64; tile += F.G) {
        const int pos0 = tile * 64;
#pragma unroll 4
        for (int k = 0; k < 16; ++k) { const int row = (tid >> 3) + 64 * k; const v4u v = *(const GAS v4u*)(F.ybT + (size_t)row * M + pos0 + (tid & 7) * 8);
            LAS unsigned* dst = (LAS unsigned*)(T + row * 132 + (tid & 7) * 16); dst[0] = v.x; dst[1] = v.y; dst[2] = v.z; dst[3] = v.w; }
        __syncthreads();
        for (int i = 0; i < 8; ++i) { const int p = w * 8 + i; float a[8], b[8]; float s = 0.f;
#pragma unroll
            for (int k = 0; k < 8; ++k) { const int c = 2 * lane + 128 * k;
                a[k] = bf2f(*(const LAS unsigned short*)(T + c * 132 + p * 2)); b[k] = bf2f(*(const LAS unsigned short*)(T + (c + 1) * 132 + p * 2)); s += a[k] * a[k] + b[k] * b[k]; }
            s = wave_sum(s);
            const float rb = rsq(s * (1.f / 1024.f) + EPS), ra = rsq(F.ssa[pos0 + p] * (1.f / 1024.f) + EPS), sc = rb / ra;
#pragma unroll
            for (int k = 0; k < 8; ++k) *(GAS unsigned*)(F.mrg + (size_t)(pos0 + p) * DM + 1024 + 2 * lane + 128 * k) = pk2(a[k] * sc, b[k] * sc); }
        __syncthreads();
    }
}

__device__ __forceinline__ void p_final(Frame& F, float* dst) {
    const int gw = F.vcu * NWAVES + F.wave, NGW = F.G * NWAVES, lane = F.lane;
    for (int m = gw; m < M; m += NGW) {
        const float r = rsq(F.ss3[m] * (1.0f / DM) + EPS);
        const GAS f32x4* xr = (const GAS f32x4*)(F.out + (size_t)m * DM) + lane; GAS f32x4* xw = (GAS f32x4*)(dst + (size_t)m * DM) + lane;
#pragma unroll
        for (int j = 0; j < 8; ++j) { const f32x4 g = ((const GAS f32x4*)F.final_g)[lane + 64 * j]; xw[64 * j] = xr[64 * j] * r * g; }
    }
}

constexpr int NPHASE = 8;
template <int PHMASK, int LO, int HI> __global__ void __launch_bounds__(NWAVES * 64, 2) fwd_kernel(Args args) {
    extern __shared__ __attribute__((aligned(16))) unsigned char lds_dyn[];
    {
        LAS unsigned char* l = (LAS unsigned char*)lds_dyn;
        for (int u = threadIdx.x; u < (LDS_BYTES - LDSCTL_OFF) / 4; u += NWAVES * 64) ((LAS unsigned*)(l + LDSCTL_OFF))[u] = 0u;
        __syncthreads();
        if (HI - LO > 1) (void)xcd_barrier_post((unsigned*)((gu32*)(args.ws + WS_CTL) + CW_BAR), (volatile LAS unsigned*)(l + MISC_OFF) + 8);
    }
    constexpr int lo = LO, hi = HI;
#define IN(k) (((PHMASK >> (k)) & 1) && lo <= (k) && (k) < hi)
#define SEAM(k) do { if (IN(k) && IN((k) + 1)) { CArgsP A_ = kargs(); XcdBarrier bar; bar.bar = (unsigned*)((gu32*)(A_->ws + WS_CTL) + CW_BAR); bar.x = xb_xcc_id(); \
        bar.st = (volatile LAS unsigned*)((LAS unsigned char*)lds_dyn + MISC_OFF) + 8; xcd_barrier(bar); } } while (0)

#ifndef PROBE_PHASE
#define PROBE_PHASE -1
#endif
#define NREP(k) (((k) == PROBE_PHASE) ? 2 : 1)
#define LASTREP(k) (rep == NREP(k) - 1)
#define REPSEAM(k) do { if (!LASTREP(k)) { CArgsP A_ = kargs(); XcdBarrier bar; bar.bar = (unsigned*)((gu32*)(A_->ws + WS_CTL) + CW_BAR); bar.x = xb_xcc_id(); \
        bar.st = (volatile LAS unsigned*)((LAS unsigned char*)lds_dyn + MISC_OFF) + 8; xcd_barrier(bar); } } while (0)
    if (IN(0)) for (int rep = 0; rep < NREP(0); ++rep) { Frame F; frame_ptrs(F); p0_prologue(F); REPSEAM(0); }
    SEAM(0);
    if (IN(1)) for (int rep = 0; rep < NREP(1); ++rep) {
        Frame F; frame_ptrs(F);
        {
            pg8::Gemm g{F.xn1, F.Wt_in, M, DA, DM}; pg8::StaticOrder S; S.init(M, DA, F.G, (int)blockIdx.x);
            pg8::EpiBf16<1> E{F.zu, DA, nullptr, 0, 0, 1.f};
            pg8::gemm_phase<pg8::EpiBf16<1>, pg8::StaticOrder, PG8_ALIGN, PG8_SP2>(F.lds + RING_OFF, g, S, E); }
        {
            pg8::Gemm g{F.Wt_in + (size_t)DA * DM, F.xn1, DIN - DA, M, DM}; pg8::StaticOrder S; S.init(DIN - DA, M, F.G, (int)blockIdx.x);
            pg8::Epi1b E{F.zvT, F.binT, F.sgu_norm_g, LASTREP(1) ? F.ssv : F.dum_ss};
            pg8::gemm_phase<pg8::Epi1b, pg8::StaticOrder, PG8_ALIGN, PG8_SP2>(F.lds + RING_OFF, g, S, E); }
        p1_filter_gemm(F);
        REPSEAM(1);
    }
    SEAM(1);
    if (IN(2)) for (int rep = 0; rep < NREP(2); ++rep) {
        Frame F; frame_ptrs(F);
        if (!LASTREP(2)) F.ssa = F.dum_ss;
#ifndef PROBE_SUB
#define PROBE_SUB -1
#endif
#ifdef PROBE_SGU
        for (int u = F.vcu; u < BATCH * (SEQ / 128) * NHA; u += F.G) sgu_unit(F, u, F.dum_ss);
#endif
        if (LASTREP(2) || PROBE_SUB != 1) for (int u = F.vcu; u < BATCH * (SEQ / 128) * NHA; u += F.G) sgu_unit(F, u, F.ssa);
        if (LASTREP(2) || PROBE_SUB != 0) hyena_phase(F);
        REPSEAM(2);
    }
    SEAM(2);
    if (IN(3)) for (int rep = 0; rep < NREP(3); ++rep) { Frame F; frame_ptrs(F); p3_merge(F); REPSEAM(3); }
    SEAM(3);
    if (IN(4)) for (int rep = 0; rep < NREP(4); ++rep) { Frame F; frame_ptrs(F);
        pg8::Gemm g{F.mrg, F.Wt_out, M, DM, DM}; pg8::StaticOrder S; S.init(M, DM, F.G, (int)blockIdx.x);
        pg8::Epi2 E{F.x, F.out, F.xb2, F.ssa, LASTREP(4) ? F.ss2 : F.dum_ss};
        pg8::gemm_phase<pg8::Epi2, pg8::StaticOrder, PG8_ALIGN, PG8_SP2>(F.lds + RING_OFF, g, S, E);
        REPSEAM(4);
    }
    SEAM(4);
    if (IN(5)) for (int rep = 0; rep < NREP(5); ++rep) { Frame F; frame_ptrs(F);
        pg8::Gemm g{F.xb2 - DM, F.Wt_up, M, NUP, DM, 254}; pg8::StaticOrder S; S.init_tiles(65, NUP / 256, F.G, (int)blockIdx.x);
        pg8::Epi3 E{F.hb, F.ss2, F.dw_w, F.dw_b, (PG8_LAS float*)(F.lds + RING_BYTES)};
        pg8::gemm_phase<pg8::Epi3, pg8::StaticOrder, true, PG8_SP2>(F.lds + RING_OFF, g, S, E);
        REPSEAM(5);
    }
    SEAM(5);
    if (IN(6)) for (int rep = 0; rep < NREP(6); ++rep) { Frame F; frame_ptrs(F);
        pg8::Gemm g{F.hb, F.Wt_dn, M, DM, DFF}; pg8::StaticOrder S; S.init(M, DM, F.G, (int)blockIdx.x);
        pg8::Epi4 E{F.out, LASTREP(6) ? F.out : F.dum_out, LASTREP(6) ? F.ss3 : F.dum_ss};
        pg8::gemm_phase<pg8::Epi4, pg8::StaticOrder, PG8_ALIGN, PG8_SP2>(F.lds + RING_OFF, g, S, E);
        REPSEAM(6);
    }
    SEAM(6);
    if (IN(7)) for (int rep = 0; rep < NREP(7); ++rep) { Frame F; frame_ptrs(F); p_final(F, LASTREP(7) ? F.out : F.dum_out); REPSEAM(7); }
#undef IN
#undef SEAM
}

#ifndef MK_LAUNCHES
#define MK_LAUNCHES 1
#endif
template <int MASK, int LO, int HI> static bool launch_phases(int grid, Args a, hipStream_t stream) {
    static bool attr_done = false;
    if (!attr_done) { if (hipFuncSetAttribute((const void*)fwd_kernel<MASK, LO, HI>, hipFuncAttributeMaxDynamicSharedMemorySize, LDS_BYTES) != hipSuccess) { fprintf(stderr, "kernel_launch: hipFuncSetAttribute failed\n"); return false; } attr_done = true; }
    a.ph_lo = LO; a.ph_hi = HI; a.li = 0;
    hipLaunchKernelGGL((fwd_kernel<MASK, LO, HI>), dim3(grid), dim3(NWAVES * 64), LDS_BYTES, stream, a);
    return true;
}
extern "C" void kernel_launch(void* const* d_in, const int* in_sizes, int n_in, void* d_out, int out_size, void* d_ws, size_t ws_size, hipStream_t stream) {
    static int grid = 0;
    if (grid == 0) {
        if (n_in != 26 || out_size != M * DM || ws_size < WS_END) { fprintf(stderr, "kernel_launch: unexpected shapes: n_in %d out %d ws %zu\n", n_in, out_size, ws_size); grid = -1; return; }
        int dev = 0, cus = 0;
        if (hipGetDevice(&dev) != hipSuccess || hipDeviceGetAttribute(&cus, hipDeviceAttributeMultiprocessorCount, dev) != hipSuccess) { grid = -1; return; }
        (void)hipGetLastError();
        grid = cus;
    }
    if (grid < 0) return;
    (void)hipMemsetAsync((char*)d_ws + WS_CTL, 0, CTL_ZERO_BYTES, stream);
    Args a{};
    for (int i = 0; i < 26; ++i) a.in[i] = (const float*)d_in[i];
    a.out = (float*)d_out; a.ws = (unsigned char*)d_ws;
#if MK_LAUNCHES == 1
    launch_phases<0xFF, 0, NPHASE>(grid, a, stream);
#else
    launch_phases<0x01, 0, 1>(grid, a, stream);
    launch_phases<0x02, 1, 2>(grid, a, stream);
    launch_phases<0x04, 2, 3>(grid, a, stream);
    launch_phases<0x08, 3, 4>(grid, a, stream);
    launch_phases<0x10, 4, 5>(grid, a, stream);
    launch_phases<0x20, 5, 6>(grid, a, stream);
    launch_phases<0x40, 6, 7>(grid, a, stream);
    launch_phases<0x80, 7, 8>(grid, a, stream);
#endif
}
```

```cpp
#include <hip/hip_runtime.h>
#include <cstdio>
#include <cstdint>
namespace pg8 {
#define PG8_LAS __attribute__((address_space(3)))
typedef unsigned short bf16_t;
typedef short bf16x8 __attribute__((ext_vector_type(8)));
typedef float f32x4 __attribute__((ext_vector_type(4)));
typedef unsigned u32x4 __attribute__((ext_vector_type(4)));
constexpr int BM = 256, BK = 64, HALF = 128, HTB = HALF * BK * 2  , STAGE_BYTES = 8 * HTB, NXCD = 8, WGM = 8;

__host__ __device__ __forceinline__ int lds_byte(int r, int c) { const int st = (r >> 4) * 2 + (c >> 5), rr = r & 15, cc = c & 31, ob = rr * 64 + cc * 2; return st * 1024 + (ob ^ (((ob >> 9) & 1) << 5)); }
__host__ __device__ __forceinline__ void stage_rc(int b, int& R, int& C) { const int st = b / 1024, sb = b % 1024, swz = sb ^ (((sb >> 9) & 1) << 5); R = (st >> 1) * 16 + swz / 64; C = (st & 1) * 32 + (swz % 64) / 2; }
__host__ __device__ __forceinline__ int perm32(int rho) { const int n = rho >> 4, i = rho & 15; return 8 * (i >> 2) + 4 * n + (i & 3); }

struct Unit { int pm, pn; };
struct Gemm { const bf16_t* A; const bf16_t* Bt; int M, N, K; int a_rows = 256; };

struct StaticOrder {
    int nM, nN, nwg, G, c;
    __host__ __device__ void init(int M, int N, int G_, int c_) { nM = M / BM; nN = N / BM; nwg = nM * nN; G = G_; c = c_; }
    __host__ __device__ void init_tiles(int nM_, int nN_, int G_, int c_) { nM = nM_; nN = nN_; nwg = nM * nN; G = G_; c = c_; }
    __host__ __device__ bool next(int i, Unit& u) const {
        const long L = (long)i * G + c; if (L >= nwg) return false;
        int wgid = (int)L; { const int q = nwg / NXCD, r = nwg % NXCD, xcd = wgid % NXCD, off = wgid / NXCD; wgid = (xcd < r ? xcd * (q + 1) : r * (q + 1) + (xcd - r) * q) + off; }
        const int nig = WGM * nN, gid = wgid / nig, fm = gid * WGM, gsz = (nM - fm) < WGM ? (nM - fm) : WGM;
        u.pm = fm + ((wgid % nig) % gsz); u.pn = (wgid % nig) / gsz; return true;
    }
    __device__ __forceinline__ void a_ready(const Unit&) const {}
    __device__ __forceinline__ void done(const Unit&) const {}
};

__device__ __forceinline__ unsigned cvt_pk_bf16(float lo, float hi) { unsigned r; asm volatile("v_cvt_pk_bf16_f32 %0, %1, %2" : "=v"(r) : "v"(lo), "v"(hi)); return r; }
typedef float f32x2 __attribute__((ext_vector_type(2)));
__device__ __forceinline__ f32x2 gelu_pk(f32x2 v) {
    const f32x2 av = __builtin_elementwise_abs(v), d = av * 0.2316418882f + 1.0f;
    f32x2 t; t.x = __builtin_amdgcn_rcpf(d.x); t.y = __builtin_amdgcn_rcpf(d.y);
    f32x2 q = t * 0.5307027145f + (-0.7265760135f); q = q * t + 0.7107068705f; q = q * t + (-0.142248368f); q = q * t + 0.127414796f; q = q * t;
    const f32x2 s = (v * v) * (-0.72134752044f);
    f32x2 e; e.x = __builtin_amdgcn_exp2f(s.x); e.y = __builtin_amdgcn_exp2f(s.y);
    const f32x2 m = v * (q * e), r = v - m;
    f32x2 o; o.x = v.x < 0.f ? m.x : r.x; o.y = v.y < 0.f ? m.y : r.y; return o;
}

template <int ACT  > struct EpiBf16 {
    static constexpr bool PERM = true, AFTER_DRAIN = false; static_assert(ACT == 0 || ACT == 1, "EpiBf16: ACT is 0 (none) or 1 (gelu_pk)");
    bf16_t* O; int ldc; const float* bias; int split_cols; size_t split_stride; float scale0;
    __device__ __forceinline__ void operator()(const f32x4 (&acc)[2][2][4][2], const Unit& u, int wr, int wc, int fr, int fq) const {
        const int row0 = u.pm * BM + wr * 64 + fr; int colt = u.pn * BM; bf16_t* base = O;
        float sc = 1.f; if (split_cols) { const int t = colt / split_cols; base += (size_t)t * split_stride; colt -= t * split_cols; if (t == 0) sc = scale0; }
        const int col0 = colt + wc * 32 + 8 * fq, bcol0 = u.pn * BM + wc * 32 + 8 * fq;
        f32x4 bv[2][2];
#pragma unroll
        for (int bj = 0; bj < 2; ++bj)
#pragma unroll
            for (int n = 0; n < 2; ++n) bv[bj][n] = bias ? *(const f32x4*)(bias + bcol0 + bj * HALF + 4 * n) : (f32x4){0.f, 0.f, 0.f, 0.f};
#pragma unroll
        for (int ai = 0; ai < 2; ++ai)
#pragma unroll
            for (int m = 0; m < 4; ++m) { bf16_t* rowp = base + (size_t)(row0 + ai * HALF + m * 16) * ldc + col0;
#pragma unroll
                for (int bj = 0; bj < 2; ++bj) { f32x4 v0 = acc[ai][bj][m][0] + bv[bj][0], v1 = acc[ai][bj][m][1] + bv[bj][1];
                    if (ACT == 1) { f32x2 a = gelu_pk((f32x2){v0[0], v0[1]}), b = gelu_pk((f32x2){v0[2], v0[3]}), c = gelu_pk((f32x2){v1[0], v1[1]}), d = gelu_pk((f32x2){v1[2], v1[3]});
                        v0 = (f32x4){a.x, a.y, b.x, b.y}; v1 = (f32x4){c.x, c.y, d.x, d.y}; }
                    v0 = v0 * sc; v1 = v1 * sc; u32x4 w; w.x = cvt_pk_bf16(v0[0], v0[1]); w.y = cvt_pk_bf16(v0[2], v0[3]); w.z = cvt_pk_bf16(v1[0], v1[1]); w.w = cvt_pk_bf16(v1[2], v1[3]);
                    *(u32x4*)(rowp + bj * HALF) = w; } }
    }
};
template <class Epi, class Sched, bool ALIGN_EPI = false, bool SP2 = false>
__device__ __forceinline__ void gemm_phase(PG8_LAS unsigned char* lds, const Gemm g, const Sched& S, const Epi& E) {
    int tid_ = threadIdx.x; asm volatile("" : "+v"(tid_));
    const int tid = tid_, wid = __builtin_amdgcn_readfirstlane(tid >> 6), lane = tid & 63, wr = wid >> 2, wc = wid & 3, fr = lane & 15, fq = lane >> 4;
    const int K = g.K, nt = K / BK;
    unsigned voffA[2], voffB[2];
#pragma unroll
    for (int i = 0; i < 2; ++i) { int R, C; stage_rc(tid * 16 + i * 8192, R, C); const int Rb = Epi::PERM ? ((R & ~31) + perm32(R & 31)) : R;
        voffA[i] = (unsigned)(R * K + C) * 2u; voffB[i] = (unsigned)(Rb * K + C) * 2u; }
    const size_t kstep = (size_t)(BK * 2);
    const size_t hstep = (size_t)HALF * K * 2;
    const size_t tstep = 2 * hstep;
    const size_t astep = (size_t)g.a_rows * K * 2;
    const unsigned ldsw = (unsigned)wid * 1024u;
    const int aoff = lds_byte(wr * 64 + fr, fq * 8), boff = lds_byte(wc * 32 + fr, fq * 8);
#define PG8_SA(b, h) (((b) * 2 + (h)) * HTB)
#define PG8_SB(b, h) ((4 + (b) * 2 + (h)) * HTB)
#define PG8_STAGE(bufoff, gbase, voff) do { _Pragma("unroll") for (int _i = 0; _i < 2; ++_i) \
        __builtin_amdgcn_global_load_lds((const unsigned*)((const char*)(gbase) + (voff)[_i]), (PG8_LAS unsigned*)(lds + (bufoff) + ldsw + _i * 8192), 16, 0, 0); } while (0)
#define PG8_LDA(dst, b, h) do { _Pragma("unroll") for (int m = 0; m < 4; ++m) _Pragma("unroll") for (int k = 0; k < 2; ++k) dst[m][k] = *(const PG8_LAS bf16x8*)(lds + PG8_SA(b, h) + aoff + m * 2048 + k * 1024); } while (0)
#define PG8_LDB(dst, b, h) do { _Pragma("unroll") for (int n = 0; n < 2; ++n) _Pragma("unroll") for (int k = 0; k < 2; ++k) dst[n][k] = *(const PG8_LAS bf16x8*)(lds + PG8_SB(b, h) + boff + n * 2048 + k * 1024); } while (0)
#define PG8_MMA(ai, bj, At, Bt) do { __builtin_amdgcn_s_setprio(1); _Pragma("unroll") for (int m = 0; m < 4; ++m) _Pragma("unroll") for (int n = 0; n < 2; ++n) _Pragma("unroll") for (int k = 0; k < 2; ++k) \
        acc[ai][bj][m][n] = __builtin_amdgcn_mfma_f32_16x16x32_bf16(Bt[n][k], At[m][k], acc[ai][bj][m][n], 0, 0, 0); __builtin_amdgcn_s_setprio(0); } while (0)
#define PG8_WAIT_V(n) asm volatile("s_waitcnt vmcnt(" #n ")" ::: "memory")
#define PG8_WAIT_L(n) asm volatile("s_waitcnt lgkmcnt(" #n ")" ::: "memory")
#define PG8_BAR __builtin_amdgcn_s_barrier()
#define PG8_SCHED __builtin_amdgcn_sched_barrier(0)
    Unit cur, nxt; int ui = 0;
    if (!S.next(0, cur)) return;
    f32x4 acc[2][2][4][2];
#pragma unroll
    for (int a = 0; a < 2; ++a)
#pragma unroll
        for (int b = 0; b < 2; ++b)
#pragma unroll
            for (int m = 0; m < 4; ++m)
#pragma unroll
                for (int n = 0; n < 2; ++n) acc[a][b][m][n] = (f32x4){0.f, 0.f, 0.f, 0.f};
    bf16x8 At[4][2], B0[2][2], B1[2][2];
    const char* cA = (const char*)g.A + (size_t)cur.pm * astep; const char* cB = (const char*)g.Bt + (size_t)cur.pn * tstep;
    S.a_ready(cur);
    if constexpr (SP2) {
        PG8_STAGE(PG8_SB(0, 0), cB, voffB); PG8_STAGE(PG8_SB(0, 1), cB + hstep, voffB); PG8_STAGE(PG8_SA(0, 0), cA, voffA); PG8_STAGE(PG8_SA(0, 1), cA + hstep, voffA);
        if (wr == 1) PG8_BAR;
        PG8_WAIT_V(2); PG8_BAR;
        PG8_STAGE(PG8_SB(1, 0), cB + kstep, voffB); PG8_STAGE(PG8_SA(1, 0), cA + kstep, voffA); PG8_STAGE(PG8_SB(1, 1), cB + hstep + kstep, voffB);
        PG8_WAIT_V(6); PG8_BAR;
    } else {
        PG8_STAGE(PG8_SB(0, 0), cB, voffB); PG8_STAGE(PG8_SA(0, 0), cA, voffA); PG8_STAGE(PG8_SB(0, 1), cB + hstep, voffB); PG8_STAGE(PG8_SA(0, 1), cA + hstep, voffA);
        if (wr == 1) PG8_BAR;
        PG8_WAIT_V(4); PG8_BAR;
        PG8_STAGE(PG8_SB(1, 0), cB + kstep, voffB); PG8_STAGE(PG8_SA(1, 0), cA + kstep, voffA); PG8_STAGE(PG8_SB(1, 1), cB + hstep + kstep, voffB);
        PG8_WAIT_V(6); PG8_BAR;
    }
    for (;;) {
        const bool has_next = S.next(ui + 1, nxt);
        const char* nA = has_next ? (const char*)g.A + (size_t)nxt.pm * astep : cA; const char* nB = has_next ? (const char*)g.Bt + (size_t)nxt.pn * tstep : cB;
        for (int t = 0; t < nt; t += 2) {
            const bool last = (t == nt - 2);
            const char* a1 = cA + (size_t)(t + 1) * kstep;
            const char* a2 = last ? nA : cA + (size_t)(t + 2) * kstep; const char* b2 = last ? nB : cB + (size_t)(t + 2) * kstep;
            const char* a3 = a2 + kstep; const char* b3 = b2 + kstep;
            if (last && has_next) S.a_ready(nxt);
            if constexpr (SP2) {
            PG8_LDB(B0, 0, 0); PG8_LDB(B1, 0, 1); PG8_SCHED; PG8_LDA(At, 0, 0); PG8_STAGE(PG8_SA(1, 1), a1 + hstep, voffA);
            PG8_WAIT_V(8); PG8_WAIT_L(0); PG8_BAR; PG8_MMA(0, 0, At, B0); PG8_MMA(0, 1, At, B1); PG8_BAR; PG8_SCHED;
            PG8_LDA(At, 0, 1); PG8_STAGE(PG8_SB(0, 0), b2, voffB); PG8_STAGE(PG8_SB(0, 1), b2 + hstep, voffB); PG8_STAGE(PG8_SA(0, 0), a2, voffA);
            PG8_WAIT_V(8); PG8_WAIT_L(0); PG8_BAR; PG8_MMA(1, 0, At, B0); PG8_MMA(1, 1, At, B1); PG8_BAR; PG8_SCHED;
            PG8_LDB(B0, 1, 0); PG8_LDB(B1, 1, 1); PG8_SCHED; PG8_LDA(At, 1, 0); PG8_STAGE(PG8_SA(0, 1), a2 + hstep, voffA);
            PG8_WAIT_V(8); PG8_WAIT_L(0); PG8_BAR; PG8_MMA(0, 0, At, B0); PG8_MMA(0, 1, At, B1); PG8_BAR; PG8_SCHED;
            PG8_LDA(At, 1, 1); PG8_STAGE(PG8_SB(1, 0), b3, voffB); PG8_STAGE(PG8_SB(1, 1), b3 + hstep, voffB); PG8_STAGE(PG8_SA(1, 0), a3, voffA);
            PG8_WAIT_V(8); PG8_WAIT_L(0); PG8_BAR; PG8_MMA(1, 0, At, B0); PG8_MMA(1, 1, At, B1); PG8_BAR; PG8_SCHED;
            } else {
            PG8_LDB(B0, 0, 0); PG8_SCHED; PG8_LDA(At, 0, 0); PG8_STAGE(PG8_SA(1, 1), a1 + hstep, voffA);
            PG8_WAIT_L(8); PG8_BAR; PG8_WAIT_L(0); PG8_MMA(0, 0, At, B0); PG8_BAR; PG8_SCHED;
            PG8_LDB(B1, 0, 1); PG8_STAGE(PG8_SB(0, 0), b2, voffB);
            PG8_BAR; PG8_WAIT_L(0); PG8_MMA(0, 1, At, B1); PG8_BAR;
            PG8_LDA(At, 0, 1); PG8_STAGE(PG8_SA(0, 0), a2, voffA);
            PG8_BAR; PG8_WAIT_L(0); PG8_MMA(1, 0, At, B0); PG8_BAR; PG8_SCHED;
            PG8_STAGE(PG8_SB(0, 1), b2 + hstep, voffB);
            PG8_WAIT_V(6); PG8_BAR; PG8_MMA(1, 1, At, B1); PG8_BAR;
            PG8_LDB(B0, 1, 0); PG8_SCHED; PG8_LDA(At, 1, 0); PG8_STAGE(PG8_SA(0, 1), a2 + hstep, voffA);
            PG8_WAIT_L(8); PG8_BAR; PG8_WAIT_L(0); PG8_MMA(0, 0, At, B0); PG8_BAR; PG8_SCHED;
            PG8_LDB(B1, 1, 1); PG8_STAGE(PG8_SB(1, 0), b3, voffB);
            PG8_BAR; PG8_WAIT_L(0); PG8_MMA(0, 1, At, B1); PG8_BAR;
            PG8_LDA(At, 1, 1); PG8_STAGE(PG8_SA(1, 0), a3, voffA);
            PG8_BAR; PG8_WAIT_L(0); PG8_MMA(1, 0, At, B0); PG8_BAR; PG8_SCHED;
            PG8_STAGE(PG8_SB(1, 1), b3 + hstep, voffB);
            PG8_WAIT_V(6); PG8_BAR; PG8_MMA(1, 1, At, B1); PG8_BAR;
            }
        }
        if constexpr (ALIGN_EPI) { if (wr == 0) PG8_BAR; }
        if constexpr (!Epi::AFTER_DRAIN) { E(acc, cur, wr, wc, fr, fq); S.done(cur); }
        if (!has_next) break;
#pragma unroll
        for (int a = 0; a < 2; ++a)
#pragma unroll
            for (int b = 0; b < 2; ++b)
#pragma unroll
                for (int m = 0; m < 4; ++m)
#pragma unroll
                    for (int n = 0; n < 2; ++n) acc[a][b][m][n] = (f32x4){0.f, 0.f, 0.f, 0.f};
        cur = nxt; cA = nA; cB = nB; ++ui;
        if constexpr (ALIGN_EPI) { if (wr == 1) PG8_BAR; }
    }
    PG8_WAIT_V(0);
    if constexpr (!ALIGN_EPI) { if (wr == 0) PG8_BAR; }
    PG8_BAR;
    if constexpr (Epi::AFTER_DRAIN) { E.fused(acc, cur, wr, wc, fr, fq, lds, wid, lane); S.done(cur); }
#undef PG8_SA
#undef PG8_SB
#undef PG8_STAGE
#undef PG8_LDA
#undef PG8_LDB
#undef PG8_MMA
#undef PG8_WAIT_V
#undef PG8_WAIT_L
#undef PG8_BAR
#undef PG8_SCHED
}
}

#ifndef PG8_SP2
#define PG8_SP2 true
#endif
#ifndef PG8_ALIGN
#define PG8_ALIGN true
#endif

constexpr int NWAVES = 8;
constexpr int BATCH = 2, SEQ = 8192, DM = 2048, M = BATCH * SEQ;
constexpr int DA = 1024, DB = 1024, NHA = 8, DIN = 5120, DFF = 5504, NUP = 2 * DFF;
constexpr float EPS = 1e-6f;
constexpr int FORD = 64;

constexpr size_t MiB = 1u << 20;
constexpr size_t WS_CTL = 0, CTL_ZERO_BYTES = 65536;
constexpr size_t WS_SS = 1 * MiB;
constexpr size_t WS_WIN = 2 * MiB, WS_WOUT = 22 * MiB, WS_WUP = 30 * MiB, WS_WDN = 73 * MiB;
constexpr size_t WS_XN1 = 96 * MiB, WS_ZU = 160 * MiB, WS_ZVT = 192 * MiB, WS_BINT = 224 * MiB;
constexpr size_t WS_H3 = 320 * MiB, WS_HT = 322 * MiB, WS_YBT = 386 * MiB, WS_MRG = 418 * MiB;
constexpr size_t WS_H = 96 * MiB;
constexpr size_t WS_XB2 = 269 * MiB;
constexpr size_t WS_GVH = 336 * MiB;
constexpr size_t WS_KBUF = 96 * MiB;
constexpr size_t WS_DUMOUT = 336 * MiB;
constexpr size_t WS_END = 508 * MiB;
constexpr int CW_TMO = 0, CW_CODE = 1, CW_BAR = 4096;

constexpr int RING_OFF = 0, RING_BYTES = 131072;
constexpr int LDS_BYTES = 163840;
constexpr int LDSCTL_OFF = LDS_BYTES - 1024, MISC_OFF = LDSCTL_OFF + 320;
constexpr int RED_OFF = MISC_OFF + 128;
static_assert(RED_OFF + 256 <= LDS_BYTES, "LDS map");

#define GAS __attribute__((address_space(1)))
#define LAS __attribute__((address_space(3)))
typedef unsigned short bf16;
typedef unsigned v4u __attribute__((ext_vector_type(4)));
typedef float f32x4 __attribute__((ext_vector_type(4)));
typedef short bf16x8 __attribute__((ext_vector_type(8)));
typedef GAS unsigned gu32;
typedef GAS unsigned long long gu64;
#define RLX_AGENT __ATOMIC_RELAXED, __HIP_MEMORY_SCOPE_AGENT
#define LDS_WAIT() asm volatile("s_waitcnt lgkmcnt(0)" ::: "memory")
#define VM_WAIT() asm volatile("s_waitcnt vmcnt(0)" ::: "memory")
__device__ __forceinline__ unsigned long long rt() { return __builtin_amdgcn_s_memrealtime(); }
__device__ __forceinline__ unsigned f2bf(float f) { unsigned u = __builtin_bit_cast(unsigned, f); return (u + 0x7fffu + ((u >> 16) & 1u)) >> 16; }
__device__ __forceinline__ unsigned pk2(float lo, float hi) { return f2bf(lo) | (f2bf(hi) << 16); }

#define XB_TMO      128
#define XB_XCNT(j)  (256  + 64 * (j))
#define XB_XSUB(j)  (1280 + 64 * (j))
#define XB_XGEN(j)  (2304 + 64 * (j))
#define XB_TOP      3328
#define XB_TOPGEN   3392
#define XCD_BAR_WORDS 3456
#define XB_SPIN_CAP (1u << 18)

__device__ __forceinline__ unsigned xb_ld(unsigned* p)              { return __hip_atomic_load(p, __ATOMIC_RELAXED, __HIP_MEMORY_SCOPE_AGENT); }
__device__ __forceinline__ unsigned xb_add(unsigned* p, unsigned v) { return __hip_atomic_fetch_add(p, v, __ATOMIC_RELAXED, __HIP_MEMORY_SCOPE_AGENT); }
__device__ __forceinline__ unsigned xb_xcc_id() { return (unsigned)__builtin_amdgcn_s_getreg((3 << 11) | 20) & 0xFu; }
#define XB_SPIN(cond, bar) do { unsigned _sp = 0; while (cond) { __builtin_amdgcn_s_sleep(1); \
    if ((++_sp & 255u) == 0u) { if (xb_ld(&(bar)[XB_TMO])) break; if (_sp > XB_SPIN_CAP) { atomicAdd(&(bar)[XB_TMO], 1u); break; } } } } while (0)

struct XcdBarrier {
    unsigned* bar; unsigned x;
    volatile LAS unsigned* st;
};

__device__ __forceinline__ XcdBarrier xcd_barrier_post(unsigned* bar, volatile LAS unsigned* st) {
    XcdBarrier b; b.bar = bar; b.x = xb_xcc_id(); b.st = st;
    if (threadIdx.x == 0) (void)xb_add(&bar[XB_XCNT(b.x)], 1u);
    return b;
}
__device__ __forceinline__ void xcd_barrier_complete(unsigned* bar, unsigned x, unsigned& nloc, unsigned& nx) {
    const unsigned G = gridDim.x * gridDim.y * gridDim.z;
    unsigned sum, cnt, mine, sp = 0u;
    for (;;) {
        sum = 0u; cnt = 0u; mine = 0u;
#pragma unroll
        for (unsigned j = 0; j < 16; ++j) { const unsigned c = xb_ld(&bar[XB_XCNT(j)]); sum += c; cnt += (c > 0u) ? 1u : 0u; mine = (j == x) ? c : mine; }
        if (sum == G) break;
        __builtin_amdgcn_s_sleep(1);
        if ((++sp & 255u) == 0u) { if (xb_ld(&bar[XB_TMO])) break; if (sp > XB_SPIN_CAP) { atomicAdd(&bar[XB_TMO], 1u); break; } }
    }
    nloc = mine > 0u ? mine : 1u; nx = cnt > 0u ? cnt : 1u;
}

__device__ __forceinline__ void xcd_barrier(const XcdBarrier& b) {
    asm volatile("s_waitcnt vmcnt(0)" ::: "memory");
    __syncthreads();
    if (threadIdx.x == 0) {
        unsigned* bar = b.bar;
        __builtin_amdgcn_s_waitcnt(0);
        unsigned nloc = b.st[0], nx = b.st[1];
        if (nloc == 0u) { xcd_barrier_complete(bar, b.x, nloc, nx); b.st[0] = nloc; b.st[1] = nx; }
        const unsigned old = xb_add(&bar[XB_XSUB(b.x)], 1u);
        const unsigned gen = old / nloc;
        if (old + 1u == (gen + 1u) * nloc) {
            __builtin_amdgcn_fence(__ATOMIC_RELEASE, "agent");
            asm volatile("s_waitcnt vmcnt(0)" ::: "memory");
            const unsigned og = xb_add(&bar[XB_TOP], 1u);
            const unsigned tg = og / nx;
            if (og + 1u == (tg + 1u) * nx) xb_add(&bar[XB_TOPGEN], 1u);
            else XB_SPIN(xb_ld(&bar[XB_TOPGEN]) == tg, bar);
            __builtin_amdgcn_fence(__ATOMIC_ACQUIRE, "agent");
            xb_add(&bar[XB_XGEN(b.x)], 1u);
            asm volatile("s_waitcnt vmcnt(0)" ::: "memory");
        } else {
            XB_SPIN(xb_ld(&bar[XB_XGEN(b.x)]) == gen, bar);
            __builtin_amdgcn_fence(__ATOMIC_ACQUIRE, "agent");
            asm volatile("s_waitcnt vmcnt(0)" ::: "memory");
        }
    }
    __syncthreads();
}
#ifndef FFT_HD
#define FFT_HD __device__ __forceinline__
#define FFT_LDS __attribute__((address_space(3)))
#endif
#if defined(__clang__)
typedef float cpx __attribute__((ext_vector_type(2)));
#else
struct cpx { float x, y; };
#endif
#if defined(__HIP_DEVICE_COMPILE__)
FFT_HD float f_add(float a, float b) { float r; asm("v_add_f32_e32 %0, %1, %2" : "=v"(r) : "v"(a), "v"(b)); return r; }
FFT_HD float f_sub(float a, float b) { float r; asm("v_sub_f32_e32 %0, %1, %2" : "=v"(r) : "v"(a), "v"(b)); return r; }
FFT_HD float f_mul(float a, float b) { float r; asm("v_mul_f32_e32 %0, %1, %2" : "=v"(r) : "v"(a), "v"(b)); return r; }
FFT_HD float f_fma(float a, float b, float c) { float r; asm("v_fma_f32 %0, %1, %2, %3" : "=v"(r) : "v"(a), "v"(b), "v"(c)); return r; }
FFT_HD float f_fnma(float a, float b, float c) { float r; asm("v_fma_f32 %0, -%1, %2, %3" : "=v"(r) : "v"(a), "v"(b), "v"(c)); return r; }
#else
FFT_HD float f_add(float a, float b) { return a + b; }
FFT_HD float f_sub(float a, float b) { return a - b; }
FFT_HD float f_mul(float a, float b) { return a * b; }
FFT_HD float f_fma(float a, float b, float c) { return a * b + c; }
FFT_HD float f_fnma(float a, float b, float c) { return c - a * b; }
#endif
FFT_HD cpx c_add(cpx a, cpx b) { return cpx{f_add(a.x, b.x), f_add(a.y, b.y)}; }
FFT_HD cpx c_sub(cpx a, cpx b) { return cpx{f_sub(a.x, b.x), f_sub(a.y, b.y)}; }
FFT_HD cpx c_mul(cpx a, cpx b) { return cpx{f_fnma(a.y, b.y, f_mul(a.x, b.x)), f_fma(a.y, b.x, f_mul(a.x, b.y))}; }
constexpr int FFT_N = 16384, FFT_PHYS = FFT_N + (FFT_N >> 6) * 4;
FFT_HD int fft_p(int i) { return i + ((i >> 6) << 2); }

template <bool INV> FFT_HD void dft4(cpx& a0, cpx& a1, cpx& a2, cpx& a3) {
    const cpx s02 = c_add(a0, a2), d02 = c_sub(a0, a2), s13 = c_add(a1, a3), d13 = c_sub(a1, a3);
    a0 = c_add(s02, s13); a2 = c_sub(s02, s13);
    if (!INV) { a1 = cpx{f_add(d02.x, d13.y), f_sub(d02.y, d13.x)}; a3 = cpx{f_sub(d02.x, d13.y), f_add(d02.y, d13.x)}; }
    else      { a1 = cpx{f_sub(d02.x, d13.y), f_add(d02.y, d13.x)}; a3 = cpx{f_add(d02.x, d13.y), f_sub(d02.y, d13.x)}; }
}
FFT_HD cpx c_mulk(cpx a, float c, float s) { return cpx{f_fnma(a.y, s, f_mul(a.x, c)), f_fma(a.y, c, f_mul(a.x, s))}; }
template <bool INV> FFT_HD void dft16(cpx (&a)[16]) {
#pragma unroll
    for (int mb = 0; mb < 4; ++mb) dft4<INV>(a[mb], a[mb + 4], a[mb + 8], a[mb + 12]);
    const float C1 = 0.92387953251128674f, S1 = 0.38268343236508977f, R2 = 0.70710678118654752f;
    const float sg = INV ? 1.0f : -1.0f;
    a[5] = c_mulk(a[5], C1, sg * S1);
    a[6] = c_mulk(a[6], R2, sg * R2);
    a[7] = c_mulk(a[7], S1, sg * C1);
    a[9] = c_mulk(a[9], R2, sg * R2);
    a[10] = INV ? cpx{-a[10].y, a[10].x} : cpx{a[10].y, -a[10].x};
    a[11] = c_mulk(a[11], -R2, sg * R2);
    a[13] = c_mulk(a[13], S1, sg * C1);
    a[14] = c_mulk(a[14], -R2, sg * R2);
    a[15] = c_mulk(a[15], -C1, -sg * S1);
#pragma unroll
    for (int qa = 0; qa < 4; ++qa) dft4<INV>(a[4 * qa], a[4 * qa + 1], a[4 * qa + 2], a[4 * qa + 3]);
}
FFT_HD void fft_sincos(float frac, float& s, float& c) {
#if defined(__HIP_DEVICE_COMPILE__)
    s = __builtin_amdgcn_sinf(frac); c = __builtin_amdgcn_cosf(frac);
#else
    s = (float)sin(6.283185307179586 * (double)frac); c = (float)cos(6.283185307179586 * (double)frac);
#endif
}
template <bool INV, int S> FFT_HD void fft_pass16(FFT_LDS cpx* X, int b) {
    constexpr int n = 16 * S;
    constexpr int PS = (S >= 64) ? S + (S >> 4) : S;
    const int blk = b / S, j = b % S, base = blk * n + j;
    FFT_LDS cpx* xp = X + fft_p(base);
    cpx a[16];
    cpx w[16];
    { float sn, cs; fft_sincos((float)j / (float)n, sn, cs); w[1] = cpx{cs, INV ? sn : -sn};
      w[2] = c_mul(w[1], w[1]); w[3] = c_mul(w[2], w[1]); w[4] = c_mul(w[2], w[2]); w[5] = c_mul(w[4], w[1]); w[6] = c_mul(w[3], w[3]); w[7] = c_mul(w[4], w[3]);
      w[8] = c_mul(w[4], w[4]); w[9] = c_mul(w[8], w[1]); w[10] = c_mul(w[5], w[5]); w[11] = c_mul(w[8], w[3]); w[12] = c_mul(w[6], w[6]); w[13] = c_mul(w[8], w[5]);
      w[14] = c_mul(w[7], w[7]); w[15] = c_mul(w[8], w[7]); }
    if (!INV) {
#pragma unroll
        for (int m = 0; m < 16; ++m) a[m] = xp[PS * m];
        dft16<false>(a);
#pragma unroll
        for (int q = 0; q < 16; ++q) { cpx v = a[4 * (q & 3) + (q >> 2)]; if (q) v = c_mul(v, w[q]); xp[PS * q] = v; }
    } else {
#pragma unroll
        for (int q = 0; q < 16; ++q) { cpx v = xp[PS * q]; if (q) v = c_mul(v, w[q]); a[q] = v; }
        dft16<true>(a);
#pragma unroll
        for (int m = 0; m < 16; ++m) xp[PS * m] = a[4 * (m & 3) + (m >> 2)];
    }
}
template <bool INV> FFT_HD void fft_pass4(FFT_LDS cpx* X, int b) {
    const int p = fft_p(4 * b);
    cpx a0 = X[p], a1 = X[p + 1], a2 = X[p + 2], a3 = X[p + 3];
    dft4<INV>(a0, a1, a2, a3);
    X[p] = a0; X[p + 1] = a1; X[p + 2] = a2; X[p + 3] = a3;
}

typedef unsigned u32x2 __attribute__((ext_vector_type(2)));
struct Frame {
    LAS unsigned char* lds;
    volatile LAS unsigned* MISC;
    gu32* ctl;
    int tid, lane, wave;
    int vcu, G;
    const float *x, *norm1_g, *w_in, *sgu_norm_g, *sgu_w, *sgu_b, *hy_conv_w, *hy_conv_b;
    const float *f_w1, *f_b1, *f_w2, *f_b2, *f_w3, *f_b3, *f_freq, *f_wout, *d_skip;
    const float *on_a_g, *on_b_g, *w_out, *norm2_g, *w_up, *dw_w, *dw_b, *w_down, *final_g;
    float* out;
    float *ssv, *ssa, *ss2, *ss3, *h3, *hT, *dum_ss, *dum_out;
    bf16 *Wt_in, *Wt_out, *Wt_up, *Wt_dn, *xn1, *zu, *zvT, *binT, *ybT, *mrg, *hb, *xb2;
};
struct Args { const float* in[26]; float* out; unsigned char* ws; int ph_lo, ph_hi, li, pad; };
typedef const __attribute__((address_space(4))) Args* CArgsP;
__device__ __forceinline__ CArgsP kargs() {
    CArgsP p = (CArgsP)__builtin_amdgcn_kernarg_segment_ptr();
    asm volatile("" : "+s"(p));
    return p;
}
__device__ __forceinline__ void frame_ptrs(Frame& F) {
    extern __shared__ __attribute__((aligned(16))) unsigned char lds_dyn[];
    F.lds = (LAS unsigned char*)lds_dyn;
    F.MISC = (volatile LAS unsigned*)(F.lds + MISC_OFF);
    int tid_ = threadIdx.x; asm volatile("" : "+v"(tid_));
    F.tid = tid_; F.lane = F.tid & 63; F.wave = __builtin_amdgcn_readfirstlane(F.tid >> 6);
    int g_ = gridDim.x, bx_ = blockIdx.x; asm volatile("" : "+s"(g_), "+s"(bx_));
    F.G = g_; F.vcu = (F.G % 8 == 0) ? (bx_ % 8) * (F.G / 8) + bx_ / 8 : bx_;
    CArgsP A = kargs();
    unsigned char* ws = A->ws;
    F.ctl = (gu32*)(ws + WS_CTL);
    F.x = A->in[0]; F.norm1_g = A->in[1]; F.w_in = A->in[2]; F.sgu_norm_g = A->in[3]; F.sgu_w = A->in[4]; F.sgu_b = A->in[5];
    F.hy_conv_w = A->in[6]; F.hy_conv_b = A->in[7]; F.f_w1 = A->in[8]; F.f_b1 = A->in[9]; F.f_w2 = A->in[10]; F.f_b2 = A->in[11];
    F.f_w3 = A->in[12]; F.f_b3 = A->in[13]; F.f_freq = A->in[14]; F.f_wout = A->in[15]; F.d_skip = A->in[16];
    F.on_a_g = A->in[17]; F.on_b_g = A->in[18]; F.w_out = A->in[19]; F.norm2_g = A->in[20]; F.w_up = A->in[21];
    F.dw_w = A->in[22]; F.dw_b = A->in[23]; F.w_down = A->in[24]; F.final_g = A->in[25]; F.out = A->out;
    F.ssv = (float*)(ws + WS_SS); F.ssa = F.ssv + M; F.ss2 = F.ssa + M; F.ss3 = F.ss2 + M;
    F.h3 = (float*)(ws + WS_H3); F.hT = (float*)(ws + WS_HT); F.dum_ss = F.ssv + 4 * M; F.dum_out = (float*)(ws + WS_DUMOUT);
    F.Wt_in = (bf16*)(ws + WS_WIN); F.Wt_out = (bf16*)(ws + WS_WOUT); F.Wt_up = (bf16*)(ws + WS_WUP); F.Wt_dn = (bf16*)(ws + WS_WDN);
    F.xn1 = (bf16*)(ws + WS_XN1); F.zu = (bf16*)(ws + WS_ZU); F.zvT = (bf16*)(ws + WS_ZVT); F.binT = (bf16*)(ws + WS_BINT);
    F.ybT = (bf16*)(ws + WS_YBT); F.mrg = (bf16*)(ws + WS_MRG); F.hb = (bf16*)(ws + WS_H); F.xb2 = (bf16*)(ws + WS_XB2);
}


__device__ __forceinline__ float wave_sum(float v) {
#pragma unroll
    for (int o = 1; o < 64; o <<= 1) v += __shfl_xor(v, o);
    return v;
}
__device__ __forceinline__ float bf2f(unsigned short b) { return __builtin_bit_cast(float, ((unsigned)b) << 16); }
__device__ __forceinline__ float bflo(unsigned w) { return __builtin_bit_cast(float, w << 16); }
__device__ __forceinline__ float bfhi(unsigned w) { return __builtin_bit_cast(float, w & 0xffff0000u); }
__device__ __forceinline__ float gelu_f(float v) { return 0.5f * v * (1.0f + erff(v * 0.70710678118654752f)); }
__device__ __forceinline__ float rsq(float v) { return 1.0f / sqrtf(v); }

namespace pg8 {
struct Epi1b {
    static constexpr bool PERM = true, AFTER_DRAIN = false;
    bf16_t* zvT; bf16_t* binT; const float* g_sgu; float* ssv;
    __device__ __forceinline__ void operator()(const f32x4 (&acc)[2][2][4][2], const Unit& u, int wr, int wc, int fr, int fq) const {
        const int row0 = u.pm * BM + wr * 64 + fr, col0 = u.pn * BM + wc * 32 + 8 * fq;
        if (u.pm < 4) {
            float ss[2][8];
#pragma unroll
            for (int bj = 0; bj < 2; ++bj)
#pragma unroll
                for (int k = 0; k < 8; ++k) ss[bj][k] = 0.f;
#pragma unroll
            for (int ai = 0; ai < 2; ++ai)
#pragma unroll
                for (int m = 0; m < 4; ++m) { const int r = row0 + ai * HALF + m * 16; const float gg = g_sgu[r]; bf16_t* rowp = zvT + (size_t)r * 16384 + col0;
#pragma unroll
                    for (int bj = 0; bj < 2; ++bj) { const f32x4 v0 = acc[ai][bj][m][0], v1 = acc[ai][bj][m][1];
                        const f32x2 a = gelu_pk((f32x2){v0[0], v0[1]}), b = gelu_pk((f32x2){v0[2], v0[3]}), c = gelu_pk((f32x2){v1[0], v1[1]}), d = gelu_pk((f32x2){v1[2], v1[3]});
                        ss[bj][0] += a.x * a.x; ss[bj][1] += a.y * a.y; ss[bj][2] += b.x * b.x; ss[bj][3] += b.y * b.y;
                        ss[bj][4] += c.x * c.x; ss[bj][5] += c.y * c.y; ss[bj][6] += d.x * d.x; ss[bj][7] += d.y * d.y;
                        u32x4 w; w.x = cvt_pk_bf16(a.x * gg, a.y * gg); w.y = cvt_pk_bf16(b.x * gg, b.y * gg); w.z = cvt_pk_bf16(c.x * gg, c.y * gg); w.w = cvt_pk_bf16(d.x * gg, d.y * gg);
                        *(u32x4*)(rowp + bj * HALF) = w; } }
#pragma unroll
            for (int bj = 0; bj < 2; ++bj)
#pragma unroll
                for (int k = 0; k < 8; ++k) { float v = ss[bj][k]; v += __shfl_xor(v, 1); v += __shfl_xor(v, 2); v += __shfl_xor(v, 4); v += __shfl_xor(v, 8);
                    if (fr == 0) atomicAdd(ssv + col0 + bj * HALF + k, v); }
        } else {
#pragma unroll
            for (int ai = 0; ai < 2; ++ai)
#pragma unroll
                for (int m = 0; m < 4; ++m) { const int r = row0 + ai * HALF + m * 16 - 1024; bf16_t* rowp = binT + (size_t)r * 16384 + col0;
#pragma unroll
                    for (int bj = 0; bj < 2; ++bj) { const f32x4 v0 = acc[ai][bj][m][0], v1 = acc[ai][bj][m][1];
                        u32x4 w; w.x = cvt_pk_bf16(v0[0], v0[1]); w.y = cvt_pk_bf16(v0[2], v0[3]); w.z = cvt_pk_bf16(v1[0], v1[1]); w.w = cvt_pk_bf16(v1[2], v1[3]);
                        *(u32x4*)(rowp + bj * HALF) = w; } }
        }
    }
};
struct Epi2 {
    static constexpr bool PERM = true, AFTER_DRAIN = false;
    const float* x; float* x1; bf16_t* xb2; const float* ssa; float* ss2;
    __device__ __forceinline__ void operator()(const f32x4 (&acc)[2][2][4][2], const Unit& u, int wr, int wc, int fr, int fq) const {
        const int row0 = u.pm * BM + wr * 64 + fr, col0 = u.pn * BM + wc * 32 + 8 * fq;
#pragma unroll
        for (int ai = 0; ai < 2; ++ai)
#pragma unroll
            for (int m = 0; m < 4; ++m) { const int r = row0 + ai * HALF + m * 16; const float ra = 1.0f / sqrtf(ssa[r] * (1.0f / 1024.0f) + 1e-6f); float s = 0.f;
                const size_t off = (size_t)r * 2048 + col0;
#pragma unroll
                for (int bj = 0; bj < 2; ++bj) { const f32x4 x0 = *(const f32x4*)(x + off + bj * HALF), x4 = *(const f32x4*)(x + off + bj * HALF + 4);
                    const f32x4 v0 = x0 + acc[ai][bj][m][0] * ra, v1 = x4 + acc[ai][bj][m][1] * ra;
                    *(f32x4*)(x1 + off + bj * HALF) = v0; *(f32x4*)(x1 + off + bj * HALF + 4) = v1;
                    s += (v0[0] * v0[0] + v0[1] * v0[1]) + (v0[2] * v0[2] + v0[3] * v0[3]) + (v1[0] * v1[0] + v1[1] * v1[1]) + (v1[2] * v1[2] + v1[3] * v1[3]);
                    u32x4 w; w.x = cvt_pk_bf16(v0[0], v0[1]); w.y = cvt_pk_bf16(v0[2], v0[3]); w.z = cvt_pk_bf16(v1[0], v1[1]); w.w = cvt_pk_bf16(v1[2], v1[3]);
                    *(u32x4*)(xb2 + off + bj * HALF) = w; }
                s += __shfl_xor(s, 16); s += __shfl_xor(s, 32);
                if (fq == 0) atomicAdd(ss2 + r, s);
                asm volatile("" ::: "memory"); }
    }
};
struct Epi3 {
    static constexpr bool PERM = true, AFTER_DRAIN = false;
    bf16_t* h; const float* ss2; const float* dw_w; const float* dw_b; PG8_LAS float* E;
    __device__ __forceinline__ void operator()(const f32x4 (&acc)[2][2][4][2], const Unit& u, int wr, int wc, int fr, int fq) const {
        const int lane = fq * 16 + fr, lprev = (lane & 48) | ((lane - 1) & 15), lnext = (lane & 48) | ((lane + 1) & 15);
        const int chl = wc * 32 + 8 * fq, ch = u.pn * 128 + chl, rowbase = u.pm * 254 - 1;
        float r2[2][4];
#pragma unroll
        for (int ai = 0; ai < 2; ++ai)
#pragma unroll
            for (int m = 0; m < 4; ++m) { const int tg = rowbase + ai * HALF + wr * 64 + m * 16 + fr; r2[ai][m] = (tg >= 0 && tg < 16384) ? 1.0f / sqrtf(ss2[tg] * (1.0f / 2048.0f) + 1e-6f) : 0.f; }
#pragma unroll
        for (int ai = 0; ai < 2; ++ai) { const int kb = 2 * ai + wr;
            if (fr == 0) { *(PG8_LAS f32x4*)(E + kb * 128 + chl) = acc[ai][0][0][0] * r2[ai][0]; *(PG8_LAS f32x4*)(E + kb * 128 + chl + 4) = acc[ai][0][0][1] * r2[ai][0]; }
            if (fr == 15) { *(PG8_LAS f32x4*)(E + 512 + kb * 128 + chl) = acc[ai][0][3][0] * r2[ai][3]; *(PG8_LAS f32x4*)(E + 512 + kb * 128 + chl + 4) = acc[ai][0][3][1] * r2[ai][3]; } }
        asm volatile("s_waitcnt lgkmcnt(0)" ::: "memory"); __builtin_amdgcn_s_barrier(); asm volatile("" ::: "memory");
#pragma unroll
        for (int ai = 0; ai < 2; ++ai) { const int kb = 2 * ai + wr;
            unsigned pk[4][4];
            bool pz[4], nz[4];
#pragma unroll
            for (int m = 0; m < 4; ++m) { const int tg = rowbase + ai * HALF + wr * 64 + m * 16 + fr; pz[m] = (tg & 8191) == 0; nz[m] = (tg & 8191) == 8191; }
#pragma unroll
            for (int n = 0; n < 2; ++n)
#pragma unroll
                for (int jp = 0; jp < 2; ++jp) { const int c0 = 4 * n + 2 * jp;
                    const f32x2 w0 = *(const f32x2*)(dw_w + ch + c0), w1 = *(const f32x2*)(dw_w + 5504 + ch + c0), w2 = *(const f32x2*)(dw_w + 11008 + ch + c0), bb = *(const f32x2*)(dw_b + ch + c0);
                    f32x2 pe = (f32x2){0.f, 0.f}, ne = (f32x2){0.f, 0.f};
                    if (kb >= 1) pe = *(const PG8_LAS f32x2*)(E + 512 + (kb - 1) * 128 + chl + c0);
                    if (kb <= 2) ne = *(const PG8_LAS f32x2*)(E + (kb + 1) * 128 + chl + c0);
                    float oo[4][2];
#pragma unroll
                    for (int jj = 0; jj < 2; ++jj) { const int j = 2 * jp + jj;
                        float g[4], R[4], L[4];
#pragma unroll
                        for (int m = 0; m < 4; ++m) { g[m] = acc[ai][0][m][n][j] * r2[ai][m]; R[m] = __shfl(g[m], lprev); L[m] = __shfl(g[m], lnext); }
#pragma unroll
                        for (int m = 0; m < 4; ++m) { float gp = (fr == 0) ? ((m == 0) ? pe[jj] : R[(m + 3) & 3]) : R[m]; float gn = (fr == 15) ? ((m == 3) ? ne[jj] : L[(m + 1) & 3]) : L[m];
                            if (pz[m]) gp = 0.f; if (nz[m]) gn = 0.f;
                            oo[m][jj] = w0[jj] * gp + w1[jj] * g[m] + w2[jj] * gn + bb[jj]; } }
#pragma unroll
                    for (int m = 0; m < 4; ++m) { const f32x2 ge = gelu_pk((f32x2){oo[m][0], oo[m][1]});
                        pk[m][2 * n + jp] = cvt_pk_bf16(ge.x * acc[ai][1][m][n][2 * jp] * r2[ai][m], ge.y * acc[ai][1][m][n][2 * jp + 1] * r2[ai][m]); } }
#pragma unroll
            for (int m = 0; m < 4; ++m) { const int rl = ai * HALF + wr * 64 + m * 16 + fr, tg = rowbase + rl;
                u32x4 w; w.x = pk[m][0]; w.y = pk[m][1]; w.z = pk[m][2]; w.w = pk[m][3];
                if (rl >= 1 && rl <= 254 && tg < 16384) *(u32x4*)(h + (size_t)tg * 5504 + ch) = w; } }
    }
};
struct Epi4 {
    static constexpr bool PERM = true, AFTER_DRAIN = false;
    const float* x1; float* xo; float* ss3;
    __device__ __forceinline__ void operator()(const f32x4 (&acc)[2][2][4][2], const Unit& u, int wr, int wc, int fr, int fq) const {
        const int row0 = u.pm * BM + wr * 64 + fr, col0 = u.pn * BM + wc * 32 + 8 * fq;
#pragma unroll
        for (int ai = 0; ai < 2; ++ai)
#pragma unroll
            for (int m = 0; m < 4; ++m) { const int r = row0 + ai * HALF + m * 16; float s = 0.f; const size_t off = (size_t)r * 2048 + col0;
#pragma unroll
                for (int bj = 0; bj < 2; ++bj) { const f32x4 x0 = *(const f32x4*)(x1 + off + bj * HALF), x4 = *(const f32x4*)(x1 + off + bj * HALF + 4);
                    const f32x4 v0 = x0 + acc[ai][bj][m][0], v1 = x4 + acc[ai][bj][m][1];
                    *(f32x4*)(xo + off + bj * HALF) = v0; *(f32x4*)(xo + off + bj * HALF + 4) = v1;
                    s += (v0[0] * v0[0] + v0[1] * v0[1]) + (v0[2] * v0[2] + v0[3] * v0[3]) + (v1[0] * v1[0] + v1[1] * v1[1]) + (v1[2] * v1[2] + v1[3] * v1[3]); }
                s += __shfl_xor(s, 16); s += __shfl_xor(s, 32);
                if (fq == 0) atomicAdd(ss3 + r, s);
                asm volatile("" ::: "memory"); }
    }
};
}

template <int MODE  , bool SCALED>
__device__ __forceinline__ void p0_transpose_item(const float* W, int K, int N, bf16* WT, const float* kscale, LAS float* scr, int item, int lane) {
    const int nblk = N / 32, kb = item / nblk, nb = item % nblk, k0 = 64 * kb, n0 = 32 * nb;
    float v[32];
#pragma unroll
    for (int i = 0; i < 32; ++i) v[i] = W[(size_t)(k0 + 2 * i + (lane >> 5)) * N + n0 + (lane & 31)];
    if (SCALED) {
#pragma unroll
        for (int i = 0; i < 32; ++i) v[i] *= kscale[k0 + 2 * i + (lane >> 5)]; }
#pragma unroll
    for (int i = 0; i < 32; ++i) scr[(2 * i + (lane >> 5)) * 33 + (lane & 31)] = v[i];
    LDS_WAIT(); asm volatile("" ::: "memory");
    const int c = lane & 7;
    int r0 = n0;
    if (MODE == 1) { const int half = n0 / DFF, rem = n0 % DFF, tile = rem / 128, j = rem % 128; r0 = tile * 256 + half * 128 + j; }
#pragma unroll
    for (int j = 0; j < 4; ++j) { const int n = (lane >> 3) + 8 * j; const LAS float* s = scr + (8 * c) * 33 + n;
        v4u o; o.x = pk2(s[0 * 33], s[1 * 33]); o.y = pk2(s[2 * 33], s[3 * 33]); o.z = pk2(s[4 * 33], s[5 * 33]); o.w = pk2(s[6 * 33], s[7 * 33]);
        *(GAS v4u*)(WT + (size_t)(r0 + n) * K + k0 + 8 * c) = o; }
    LDS_WAIT(); asm volatile("" ::: "memory");
}

__device__ __forceinline__ void p0_prologue(Frame& F) {
    LAS float* scr = (LAS float*)(F.lds + RING_OFF + F.wave * 16384);
    const int gw = F.vcu * NWAVES + F.wave, NGW = F.G * NWAVES;
    const int lane = F.lane;
    for (int i = gw * 64 + lane; i < 4 * M; i += NGW * 64) F.ssv[i] = 0.f;
    constexpr int I_IN = (DM / 64) * (DIN / 32), I_OUT = (DM / 64) * (DM / 32), I_UP = (DM / 64) * (NUP / 32), I_DN = (DFF / 64) * (DM / 32);
    constexpr int NITEMS = I_IN + I_OUT + I_UP + I_DN;
    for (int it = gw; it < NITEMS; it += NGW) {
        int r = it;
        if (r < I_IN) { p0_transpose_item<0, false>(F.w_in, DM, DIN, F.Wt_in, nullptr, scr, r, lane); continue; } r -= I_IN;
        if (r < I_OUT) { const int kb = r / (DM / 32); p0_transpose_item<0, true>(F.w_out, DM, DM, F.Wt_out, (kb < 16) ? F.on_a_g : (F.on_b_g - 1024), scr, r, lane); continue; } r -= I_OUT;
        if (r < I_UP) { p0_transpose_item<1, true>(F.w_up, DM, NUP, F.Wt_up, F.norm2_g, scr, r, lane); continue; } r -= I_UP;
        p0_transpose_item<0, false>(F.w_down, DFF, DM, F.Wt_dn, nullptr, scr, r, lane);
    }
    for (int m = gw; m < M; m += NGW) {
        const GAS f32x4* xr = (const GAS f32x4*)(F.x + (size_t)m * DM) + lane;
        f32x4 v[8]; float s = 0.f;
#pragma unroll
        for (int j = 0; j < 8; ++j) { v[j] = xr[64 * j]; s += (v[j].x * v[j].x + v[j].y * v[j].y) + (v[j].z * v[j].z + v[j].w * v[j].w); }
        const float r = rsq(wave_sum(s) * (1.0f / DM) + EPS);
        GAS unsigned long long* o8 = (GAS unsigned long long*)(F.xn1 + (size_t)m * DM) + lane;
#pragma unroll
        for (int j = 0; j < 8; ++j) { const f32x4 g = ((const GAS f32x4*)F.norm1_g)[lane + 64 * j]; const f32x4 o = v[j] * r * g;
            o8[64 * j] = (unsigned long long)pk2(o.x, o.y) | ((unsigned long long)pk2(o.z, o.w) << 32); }
    }
    for (int t = gw; t < SEQ; t += NGW) {
        float z = 0.f;
        { const float tl = (float)t / (float)(SEQ - 1); const float w = (6.283185307179586f / (float)SEQ) * (float)t;
          if (lane == 0) z = tl;
          else if (lane <= 16) { const float f = 1e-4f + (float)(lane - 1) * ((15.0f - 1e-4f) / 15.0f); z = cosf(f * w); }
          else if (lane <= 32) { const float f = 1e-4f + (float)(lane - 17) * ((15.0f - 1e-4f) / 15.0f); z = -sinf(f * w); } }
        const float fr = F.f_freq[lane];
        float a = F.f_b1[lane];
        for (int k = 0; k < 33; ++k) a += __shfl(z, k) * F.f_w1[k * 64 + lane];
        float h = sinf(fr * a);
        a = F.f_b2[lane];
        for (int k = 0; k < 64; ++k) a += __shfl(h, k) * F.f_w2[k * 64 + lane];
        h = sinf(fr * a);
        a = F.f_b3[lane];
        for (int k = 0; k < 64; ++k) a += __shfl(h, k) * F.f_w3[k * 64 + lane];
        h = sinf(fr * a);
        F.h3[(size_t)t * 64 + lane] = h;
    }
}

struct SguRaw { f32x4 wa[8]; v4u zb[4]; u32x2 zu[2][4]; float sv; };
__device__ __forceinline__ void sgu_load(Frame& F, int unit, SguRaw& R) {
    const int h = unit & 7, pos0 = (unit >> 3) * 128, t = F.tid, lane = F.lane, w = F.wave;
    { const int i = t >> 2, j0 = (t & 3) * 32; const GAS f32x4* wrow = (const GAS f32x4*)(F.sgu_w + ((size_t)h * 128 + i) * 128 + j0);
#pragma unroll
      for (int q = 0; q < 8; ++q) R.wa[q] = wrow[q]; }
    { const int d = t >> 2, c0 = (t & 3) * 32; const GAS v4u* src = (const GAS v4u*)(F.zvT + (size_t)(h * 128 + d) * M + pos0 + c0);
#pragma unroll
      for (int q = 0; q < 4; ++q) R.zb[q] = src[q]; }
    R.sv = F.ssv[pos0 + (t & 127)];
    const int iw = w & 3, dw = w >> 2, r = lane & 15, q = lane >> 4;
#pragma unroll
    for (int it = 0; it < 2; ++it)
#pragma unroll
        for (int dt = 0; dt < 4; ++dt) R.zu[it][dt] = *(const GAS u32x2*)(F.zu + (size_t)(pos0 + 32 * iw + 16 * it + r) * DA + h * 128 + 64 * dw + 16 * dt + 4 * q);
}
__device__ __forceinline__ void sgu_phase(Frame& F, float* ssa_dst) {
    LAS unsigned char* As = F.lds; LAS unsigned char* Bs = F.lds + 128 * 272; LAS float* rvs = (LAS float*)(F.lds + 2 * 128 * 272);
    const int t = F.tid, lane = F.lane, w = F.wave, NU = BATCH * (SEQ / 128) * NHA;
    int unit = F.vcu;
    SguRaw R;
    if (unit < NU) sgu_load(F, unit, R);
#pragma unroll 1
    for (; unit < NU; unit += F.G) {
        const int h = unit & 7, pos0 = (unit >> 3) * 128;
        if (t < 128) rvs[t] = rsq(R.sv * (1.f / 1024.f) + EPS);
        __syncthreads();
        {
            const int i = t >> 2, j0 = (t & 3) * 32;
#pragma unroll
            for (int q = 0; q < 4; ++q) { const f32x4 r0 = *(const LAS f32x4*)(rvs + j0 + 8 * q), r1 = *(const LAS f32x4*)(rvs + j0 + 8 * q + 4); const f32x4 w0 = R.wa[2 * q] * r0, w1 = R.wa[2 * q + 1] * r1;
                v4u o; o.x = pk2(w0.x, w0.y); o.y = pk2(w0.z, w0.w); o.z = pk2(w1.x, w1.y); o.w = pk2(w1.z, w1.w);
                *(LAS v4u*)(As + i * 272 + (j0 + 8 * q) * 2) = o; }
#pragma unroll
            for (int q = 0; q < 4; ++q) *(LAS v4u*)(Bs + i * 272 + (j0 + 8 * q) * 2) = R.zb[q];
        }
        u32x2 zu[2][4];
#pragma unroll
        for (int it = 0; it < 2; ++it)
#pragma unroll
            for (int dt = 0; dt < 4; ++dt) zu[it][dt] = R.zu[it][dt];
        asm volatile("" ::: "memory");
        if (unit + F.G < NU) sgu_load(F, unit + F.G, R);
        __syncthreads();
        const int iw = w & 3, dw = w >> 2, r = lane & 15, q = lane >> 4;
        f32x4 acc[2][4];
#pragma unroll
        for (int it = 0; it < 2; ++it)
#pragma unroll
            for (int dt = 0; dt < 4; ++dt) acc[it][dt] = (f32x4){0.f, 0.f, 0.f, 0.f};
#pragma unroll
        for (int ks = 0; ks < 4; ++ks) {
            bf16x8 a[2], b[4];
#pragma unroll
            for (int it = 0; it < 2; ++it) a[it] = *(const LAS bf16x8*)(As + (32 * iw + 16 * it + r) * 272 + (32 * ks + 8 * q) * 2);
#pragma unroll
            for (int dt = 0; dt < 4; ++dt) b[dt] = *(const LAS bf16x8*)(Bs + (64 * dw + 16 * dt + r) * 272 + (32 * ks + 8 * q) * 2);
#pragma unroll
            for (int it = 0; it < 2; ++it)
#pragma unroll
                for (int dt = 0; dt < 4; ++dt) acc[it][dt] = __builtin_amdgcn_mfma_f32_16x16x32_bf16(b[dt], a[it], acc[it][dt], 0, 0, 0);
        }
#pragma unroll
        for (int it = 0; it < 2; ++it) { const int i = 32 * iw + 16 * it + r, row = pos0 + i; const float bias = F.sgu_b[h * 128 + i]; float ss = 0.f;
#pragma unroll
            for (int dt = 0; dt < 4; ++dt) { const int col = h * 128 + 64 * dw + 16 * dt + 4 * q;
                const u32x2 zz = zu[it][dt];
                const float y0 = bflo(zz.x) * (acc[it][dt][0] + bias), y1 = bfhi(zz.x) * (acc[it][dt][1] + bias), y2 = bflo(zz.y) * (acc[it][dt][2] + bias), y3 = bfhi(zz.y) * (acc[it][dt][3] + bias);
                ss += (y0 * y0 + y1 * y1) + (y2 * y2 + y3 * y3);
                u32x2 o; o.x = pk2(y0, y1); o.y = pk2(y2, y3);
                *(GAS u32x2*)(F.mrg + (size_t)row * DM + col) = o; }
            ss += __shfl_xor(ss, 16); ss += __shfl_xor(ss, 32);
            if (q == 0) atomicAdd(ssa_dst + row, ss); }
        __syncthreads();
    }
}

typedef float f32x16 __attribute__((ext_vector_type(16)));
__device__ __forceinline__ void p1_filter_gemm(Frame& F) {
    const int gw = F.vcu * NWAVES + F.wave, NGW = F.G * NWAVES, lane = F.lane, i = lane & 31, hh = lane >> 5;
    for (int tile = gw; tile < 64 * 256; tile += NGW) { const int ct = tile >> 8, tt = tile & 255;
        f32x16 acc;
#pragma unroll
        for (int r = 0; r < 16; ++r) acc[r] = 0.f;
        const GAS f32x4* hrow = (const GAS f32x4*)(F.h3 + (size_t)(tt * 32 + i) * 64 + 32 * hh);
        const GAS float* wcol = (const GAS float*)F.f_wout + (size_t)(32 * hh) * 2048 + ct * 32 + i;
#pragma unroll
        for (int k4 = 0; k4 < 8; ++k4) { const f32x4 hv = hrow[k4];
            acc = __builtin_amdgcn_mfma_f32_32x32x2f32(wcol[(size_t)(4 * k4 + 0) * 2048], hv.x, acc, 0, 0, 0);
            acc = __builtin_amdgcn_mfma_f32_32x32x2f32(wcol[(size_t)(4 * k4 + 1) * 2048], hv.y, acc, 0, 0, 0);
            acc = __builtin_amdgcn_mfma_f32_32x32x2f32(wcol[(size_t)(4 * k4 + 2) * 2048], hv.z, acc, 0, 0, 0);
            acc = __builtin_amdgcn_mfma_f32_32x32x2f32(wcol[(size_t)(4 * k4 + 3) * 2048], hv.w, acc, 0, 0, 0); }
#pragma unroll
        for (int r = 0; r < 16; ++r) { const int row = (r & 3) + 8 * (r >> 2) + 4 * hh; F.hT[(size_t)(ct * 32 + row) * SEQ + tt * 32 + i] = acc[r]; }
    }
}

struct Raw8 { v4u v; unsigned hm, hp; };
__device__ __forceinline__ Raw8 raw8_load(const bf16* p, int pos0) {
    Raw8 r; r.v = *(const GAS v4u*)(p + pos0); r.hm = p[pos0 > 0 ? pos0 - 1 : 0]; r.hp = p[pos0 + 8 < M ? pos0 + 8 : M - 1]; return r;
}
__device__ __forceinline__ void dwc3x8(const Raw8& r, int t0, float w0, float w1, float w2, float b, float (&o)[8]) {
    float x[10];
    x[0] = (t0 > 0) ? bf2f((unsigned short)r.hm) : 0.f; x[9] = (t0 + 8 < SEQ) ? bf2f((unsigned short)r.hp) : 0.f;
    x[1] = bflo(r.v.x); x[2] = bfhi(r.v.x); x[3] = bflo(r.v.y); x[4] = bfhi(r.v.y); x[5] = bflo(r.v.z); x[6] = bfhi(r.v.z); x[7] = bflo(r.v.w); x[8] = bfhi(r.v.w);
#pragma unroll
    for (int k = 0; k < 8; ++k) o[k] = x[k] * w0 + x[k + 1] * w1 + x[k + 2] * w2 + b;
}
__device__ __forceinline__ void fft_fwd_all(LAS cpx* X, int tid) {
    int nb = 2; asm volatile("" : "+s"(nb));
#pragma unroll 1
    for (int i = 0; i < nb; ++i) fft_pass16<false, 1024>(X, tid + 512 * i);
    __syncthreads();
#pragma unroll 1
    for (int i = 0; i < nb; ++i) fft_pass16<false, 64>(X, tid + 512 * i);
    __syncthreads();
#pragma unroll 1
    for (int i = 0; i < nb; ++i) fft_pass16<false, 4>(X, tid + 512 * i);
    __syncthreads();
#pragma unroll 2
    for (int i = 0; i < 8; ++i) fft_pass4<false>(X, tid + 512 * i);
    __syncthreads();
}
__device__ __forceinline__ void fft_inv_all(LAS cpx* X, int tid) {
    int nb = 2; asm volatile("" : "+s"(nb));
#pragma unroll 2
    for (int i = 0; i < 8; ++i) fft_pass4<true>(X, tid + 512 * i);
    __syncthreads();
#pragma unroll 1
    for (int i = 0; i < nb; ++i) fft_pass16<true, 4>(X, tid + 512 * i);
    __syncthreads();
#pragma unroll 1
    for (int i = 0; i < nb; ++i) fft_pass16<true, 64>(X, tid + 512 * i);
    __syncthreads();
#pragma unroll 1
    for (int i = 0; i < nb; ++i) fft_pass16<true, 1024>(X, tid + 512 * i);
    __syncthreads();
}
__device__ __forceinline__ void hyena_phase(Frame& F) {
    LAS cpx* X = (LAS cpx*)F.lds; LAS float* red = (LAS float*)(F.lds + RED_OFF);
    const int tid = F.tid;
    const float min_decay = logf(1e-2f) / 1.5f, max_decay = logf(1e-2f) / 0.3f;
    int c = F.vcu;
#pragma unroll 1
    for (; c < DB; c += F.G) {
        const float delta = fabsf(min_decay + (float)c * ((max_decay - min_decay) / 1023.0f));
        const bf16* p0 = F.binT + (size_t)c * M; const bf16* p1 = F.binT + (size_t)(1024 + c) * M; const bf16* p2 = F.binT + (size_t)(2048 + c) * M;
        {
            float l1 = 0.f;
            const float* hf = F.hT + (size_t)c * SEQ; const float* hb = F.hT + (size_t)(1024 + c) * SEQ;
#pragma unroll 1
            for (int i0 = 0; i0 < 16; i0 += 8) { float vf[8], vb[8];
#pragma unroll
                for (int i = 0; i < 8; ++i) { vf[i] = hf[tid + 512 * (i0 + i)]; vb[i] = hb[tid + 512 * (i0 + i)]; }
#pragma unroll
                for (int i = 0; i < 8; ++i) { const int d = tid + 512 * (i0 + i); const float win = __expf(-((float)d * (1.0f / (float)(SEQ - 1))) * delta);
                    const float kf = vf[i] * win, kb = vb[i] * win;
                    X[fft_p(d)] = cpx{kf, 0.f}; l1 += fabsf(kf);
                    if (d >= 1) { X[fft_p(FFT_N - d)] = cpx{kb, 0.f}; l1 += fabsf(kb); } else X[fft_p(SEQ)] = cpx{0.f, 0.f}; } }
            l1 = wave_sum(l1);
            if (F.lane == 0) red[F.wave] = l1;
        }
        asm volatile("" ::: "memory");
        Raw8 r1a[2], r2a[2], r1b[2], r2b[2];
#pragma unroll
        for (int i = 0; i < 2; ++i) { const int t0 = 8 * (tid + 512 * i); r1a[i] = raw8_load(p1, t0); r2a[i] = raw8_load(p2, t0); r1b[i] = raw8_load(p1, SEQ + t0); r2b[i] = raw8_load(p2, SEQ + t0); }
        __syncthreads();
        float tot = 0.f;
#pragma unroll
        for (int i = 0; i < NWAVES; ++i) tot += red[i];
        const float scale = 1.0f / (tot + EPS);
        const float dsk = F.d_skip[c];
        fft_fwd_all(X, tid);
        typedef _Float16 h16x4 __attribute__((ext_vector_type(4)));
        h16x4 kreg[17];
        {
            const LAS f32x4* src = (const LAS f32x4*)X;
#pragma unroll
            for (int i = 0; i < 17; ++i) kreg[i] = __builtin_convertvector(src[tid + 512 * i] * scale, h16x4);
        }
        __syncthreads();
        {
            const float w10 = F.hy_conv_w[1024 + c], w11 = F.hy_conv_w[3072 + 1024 + c], w12 = F.hy_conv_w[6144 + 1024 + c], b1 = F.hy_conv_b[1024 + c];
            const float w20 = F.hy_conv_w[2048 + c], w21 = F.hy_conv_w[3072 + 2048 + c], w22 = F.hy_conv_w[6144 + 2048 + c], b2 = F.hy_conv_b[2048 + c];
#pragma unroll
            for (int i = 0; i < 2; ++i) { const int t0 = 8 * (tid + 512 * i);
                float a1[8], a2[8], c1[8], c2[8];
                dwc3x8(r1a[i], t0, w10, w11, w12, b1, a1); dwc3x8(r2a[i], t0, w20, w21, w22, b2, a2);
                dwc3x8(r1b[i], t0, w10, w11, w12, b1, c1); dwc3x8(r2b[i], t0, w20, w21, w22, b2, c2);
                LAS f32x4* dst = (LAS f32x4*)(X + fft_p(t0)); LAS f32x4* dz = (LAS f32x4*)(X + fft_p(SEQ + t0));
#pragma unroll
                for (int k = 0; k < 4; ++k) { dst[k] = (f32x4){a1[2 * k] * a2[2 * k], c1[2 * k] * c2[2 * k], a1[2 * k + 1] * a2[2 * k + 1], c1[2 * k + 1] * c2[2 * k + 1]}; dz[k] = (f32x4){0.f, 0.f, 0.f, 0.f}; } }
        }
        asm volatile("" ::: "memory");
        Raw8 r0a[2], r0b[2];
#pragma unroll
        for (int i = 0; i < 2; ++i) { const int t0 = 8 * (tid + 512 * i); r0a[i] = raw8_load(p0, t0); r0b[i] = raw8_load(p0, SEQ + t0); }
        __syncthreads();
#ifdef PROBE_FFT
        fft_fwd_all(X, tid); fft_inv_all(X, tid);
        { LAS f32x4* xx = (LAS f32x4*)X;
#pragma unroll 4
          for (int i = 0; i < 17; ++i) xx[tid + 512 * i] = xx[tid + 512 * i] * (1.0f / (float)FFT_N); }
        __syncthreads();
#endif
        fft_fwd_all(X, tid);
        {
            LAS f32x4* xx = (LAS f32x4*)X;
            const float invn = 1.0f / (float)FFT_N;
#pragma unroll
            for (int i = 0; i < 17; ++i) { const f32x4 a = xx[tid + 512 * i]; f32x4 k = __builtin_convertvector(kreg[i], f32x4); k.x += dsk; k.z += dsk;
                xx[tid + 512 * i] = (f32x4){(a.x * k.x - a.y * k.y) * invn, (a.x * k.y + a.y * k.x) * invn, (a.z * k.z - a.w * k.w) * invn, (a.z * k.w + a.w * k.z) * invn}; }
        }
        __syncthreads();
        fft_inv_all(X, tid);
        {
            const float w00 = F.hy_conv_w[c], w01 = F.hy_conv_w[3072 + c], w02 = F.hy_conv_w[6144 + c], b0 = F.hy_conv_b[c];
#pragma unroll
            for (int i = 0; i < 2; ++i) { const int t0 = 8 * (tid + 512 * i);
                float xa[8], xb[8];
                dwc3x8(r0a[i], t0, w00, w01, w02, b0, xa); dwc3x8(r0b[i], t0, w00, w01, w02, b0, xb);
                const LAS f32x4* src = (const LAS f32x4*)(X + fft_p(t0));
                const f32x4 y0 = src[0], y1 = src[1], y2 = src[2], y3 = src[3];
                v4u oa, ob;
                oa.x = pk2(xa[0] * y0.x, xa[1] * y0.z); oa.y = pk2(xa[2] * y1.x, xa[3] * y1.z); oa.z = pk2(xa[4] * y2.x, xa[5] * y2.z); oa.w = pk2(xa[6] * y3.x, xa[7] * y3.z);
                ob.x = pk2(xb[0] * y0.y, xb[1] * y0.w); ob.y = pk2(xb[2] * y1.y, xb[3] * y1.w); ob.z = pk2(xb[4] * y2.y, xb[5] * y2.w); ob.w = pk2(xb[6] * y3.y, xb[7] * y3.w);
                *(GAS v4u*)(F.ybT + (size_t)c * M + t0) = oa; *(GAS v4u*)(F.ybT + (size_t)c * M + SEQ + t0) = ob; }
        }
        __syncthreads();
    }
}

__device__ __forceinline__ void p3_merge(Frame& F) {
    for (int i = F.vcu * 512 + F.tid; i < 129 * (DM / 8); i += F.G * 512) { const int r = i / (DM / 8), q = i % (DM / 8); const int row = (r == 128) ? -1 : M + r;
        *(GAS v4u*)(F.xb2 + (ptrdiff_t)row * DM + q * 8) = (v4u){0u, 0u, 0u, 0u}; }
    LAS unsigned char* T = F.lds;
    const int tid = F.tid, lane = F.lane, w = F.wave;
    for (int tile = F.vcu; tile < M / 64; tile += F.G) {
        const int pos0 = tile * 64;
#pragma unroll 4
        for (int k = 0; k < 16; ++k) { const int row = (tid >> 3) + 64 * k; const v4u v = *(const GAS v4u*)(F.ybT + (size_t)row * M + pos0 + (tid & 7) * 8);
            LAS unsigned* dst = (LAS unsigned*)(T + row * 132 + (tid & 7) * 16); dst[0] = v.x; dst[1] = v.y; dst[2] = v.z; dst[3] = v.w; }
        __syncthreads();
        for (int i = 0; i < 8; ++i) { const int p = w * 8 + i; float a[8], b[8]; float s = 0.f;
#pragma unroll
            for (int k = 0; k < 8; ++k) { const int c = 2 * lane + 128 * k;
                a[k] = bf2f(*(const LAS unsigned short*)(T + c * 132 + p * 2)); b[k] = bf2f(*(const LAS unsigned short*)(T + (c + 1) * 132 + p * 2)); s += a[k] * a[k] + b[k] * b[k]; }
            s = wave_sum(s);
            const float rb = rsq(s * (1.f / 1024.f) + EPS), ra = rsq(F.ssa[pos0 + p] * (1.f / 1024.f) + EPS), sc = rb / ra;
#pragma unroll
            for (int k = 0; k < 8; ++k) *(GAS unsigned*)(F.mrg + (size_t)(pos0 + p) * DM + 1024 + 2 * lane + 128 * k) = pk2(a[k] * sc, b[k] * sc); }
        __syncthreads();
    }
}

__device__ __forceinline__ void p_final(Frame& F, float* dst) {
    const int gw = F.vcu * NWAVES + F.wave, NGW = F.G * NWAVES, lane = F.lane;
    for (int m = gw; m < M; m += NGW) {
        const float r = rsq(F.ss3[m] * (1.0f / DM) + EPS);
        const GAS f32x4* xr = (const GAS f32x4*)(F.out + (size_t)m * DM) + lane; GAS f32x4* xw = (GAS f32x4*)(dst + (size_t)m * DM) + lane;
#pragma unroll
        for (int j = 0; j < 8; ++j) { const f32x4 g = ((const GAS f32x4*)F.final_g)[lane + 64 * j]; xw[64 * j] = xr[64 * j] * r * g; }
    }
}

constexpr int NPHASE = 8;
template <int PHMASK, int LO, int HI> __global__ void __launch_bounds__(NWAVES * 64, 2) fwd_kernel(Args args) {
    extern __shared__ __attribute__((aligned(16))) unsigned char lds_dyn[];
    {
        LAS unsigned char* l = (LAS unsigned char*)lds_dyn;
        for (int u = threadIdx.x; u < (LDS_BYTES - LDSCTL_OFF) / 4; u += NWAVES * 64) ((LAS unsigned*)(l + LDSCTL_OFF))[u] = 0u;
        __syncthreads();
        if (HI - LO > 1) (void)xcd_barrier_post((unsigned*)((gu32*)(args.ws + WS_CTL) + CW_BAR), (volatile LAS unsigned*)(l + MISC_OFF) + 8);
    }
    constexpr int lo = LO, hi = HI;
#define IN(k) (((PHMASK >> (k)) & 1) && lo <= (k) && (k) < hi)
#define SEAM(k) do { if (IN(k) && IN((k) + 1)) { CArgsP A_ = kargs(); XcdBarrier bar; bar.bar = (unsigned*)((gu32*)(A_->ws + WS_CTL) + CW_BAR); bar.x = xb_xcc_id(); \
        bar.st = (volatile LAS unsigned*)((LAS unsigned char*)lds_dyn + MISC_OFF) + 8; xcd_barrier(bar); } } while (0)

#ifndef PROBE_PHASE
#define PROBE_PHASE -1
#endif
#define NREP(k) (((k) == PROBE_PHASE) ? 2 : 1)
#define LASTREP(k) (rep == NREP(k) - 1)
#define REPSEAM(k) do { if (!LASTREP(k)) { CArgsP A_ = kargs(); XcdBarrier bar; bar.bar = (unsigned*)((gu32*)(A_->ws + WS_CTL) + CW_BAR); bar.x = xb_xcc_id(); \
        bar.st = (volatile LAS unsigned*)((LAS unsigned char*)lds_dyn + MISC_OFF) + 8; xcd_barrier(bar); } } while (0)
    if (IN(0)) for (int rep = 0; rep < NREP(0); ++rep) { Frame F; frame_ptrs(F); p0_prologue(F); REPSEAM(0); }
    SEAM(0);
    if (IN(1)) for (int rep = 0; rep < NREP(1); ++rep) {
        Frame F; frame_ptrs(F);
        {
            pg8::Gemm g{F.xn1, F.Wt_in, M, DA, DM}; pg8::StaticOrder S; S.init(M, DA, F.G, (int)blockIdx.x);
            pg8::EpiBf16<1> E{F.zu, DA, nullptr, 0, 0, 1.f};
            pg8::gemm_phase<pg8::EpiBf16<1>, pg8::StaticOrder, PG8_ALIGN, PG8_SP2>(F.lds + RING_OFF, g, S, E); }
        {
            pg8::Gemm g{F.Wt_in + (size_t)DA * DM, F.xn1, DIN - DA, M, DM}; pg8::StaticOrder S; S.init(DIN - DA, M, F.G, (int)blockIdx.x);
            pg8::Epi1b E{F.zvT, F.binT, F.sgu_norm_g, LASTREP(1) ? F.ssv : F.dum_ss};
            pg8::gemm_phase<pg8::Epi1b, pg8::StaticOrder, PG8_ALIGN, PG8_SP2>(F.lds + RING_OFF, g, S, E); }
        p1_filter_gemm(F);
        REPSEAM(1);
    }
    SEAM(1);
    if (IN(2)) for (int rep = 0; rep < NREP(2); ++rep) {
        Frame F; frame_ptrs(F);
        if (!LASTREP(2)) F.ssa = F.dum_ss;
#ifndef PROBE_SUB
#define PROBE_SUB -1
#endif
#ifdef PROBE_SGU
        sgu_phase(F, F.dum_ss);
#endif
        if (LASTREP(2) || PROBE_SUB != 1) sgu_phase(F, F.ssa);
        if (LASTREP(2) || PROBE_SUB != 0) hyena_phase(F);
        REPSEAM(2);
    }
    SEAM(2);
    if (IN(3)) for (int rep = 0; rep < NREP(3); ++rep) { Frame F; frame_ptrs(F); p3_merge(F); REPSEAM(3); }
    SEAM(3);
    if (IN(4)) for (int rep = 0; rep < NREP(4); ++rep) { Frame F; frame_ptrs(F);
        pg8::Gemm g{F.mrg, F.Wt_out, M, DM, DM}; pg8::StaticOrder S; S.init(M, DM, F.G, (int)blockIdx.x);
        pg8::Epi2 E{F.x, F.out, F.xb2, F.ssa, LASTREP(4) ? F.ss2 : F.dum_ss};
        pg8::gemm_phase<pg8::Epi2, pg8::StaticOrder, PG8_ALIGN, PG8_SP2>(F.lds + RING_OFF, g, S, E);
        REPSEAM(4);
    }
    SEAM(4);
    if (IN(5)) for (int rep = 0; rep < NREP(5); ++rep) { Frame F; frame_ptrs(F);
        pg8::Gemm g{F.xb2 - DM, F.Wt_up, M, NUP, DM, 254}; pg8::StaticOrder S; S.init_tiles(65, NUP / 256, F.G, (int)blockIdx.x);
        pg8::Epi3 E{F.hb, F.ss2, F.dw_w, F.dw_b, (PG8_LAS float*)(F.lds + RING_BYTES)};
        pg8::gemm_phase<pg8::Epi3, pg8::StaticOrder, true, PG8_SP2>(F.lds + RING_OFF, g, S, E);
        REPSEAM(5);
    }
    SEAM(5);
    if (IN(6)) for (int rep = 0; rep < NREP(6); ++rep) { Frame F; frame_ptrs(F);
        pg8::Gemm g{F.hb, F.Wt_dn, M, DM, DFF}; pg8::StaticOrder S; S.init(M, DM, F.G, (int)blockIdx.x);
        pg8::Epi4 E{F.out, LASTREP(6) ? F.out : F.dum_out, LASTREP(6) ? F.ss3 : F.dum_ss};
        pg8::gemm_phase<pg8::Epi4, pg8::StaticOrder, PG8_ALIGN, PG8_SP2>(F.lds + RING_OFF, g, S, E);
        REPSEAM(6);
    }
    SEAM(6);
    if (IN(7)) for (int rep = 0; rep < NREP(7); ++rep) { Frame F; frame_ptrs(F); p_final(F, LASTREP(7) ? F.out : F.dum_out); REPSEAM(7); }
#undef IN
#undef SEAM
}

#ifndef MK_LAUNCHES
#define MK_LAUNCHES 1
#endif
template <int MASK, int LO, int HI> static bool launch_phases(int grid, Args a, hipStream_t stream) {
    static bool attr_done = false;
    if (!attr_done) { if (hipFuncSetAttribute((const void*)fwd_kernel<MASK, LO, HI>, hipFuncAttributeMaxDynamicSharedMemorySize, LDS_BYTES) != hipSuccess) { fprintf(stderr, "kernel_launch: hipFuncSetAttribute failed\n"); return false; } attr_done = true; }
    a.ph_lo = LO; a.ph_hi = HI; a.li = 0;
    hipLaunchKernelGGL((fwd_kernel<MASK, LO, HI>), dim3(grid), dim3(NWAVES * 64), LDS_BYTES, stream, a);
    return true;
}
extern "C" void kernel_launch(void* const* d_in, const int* in_sizes, int n_in, void* d_out, int out_size, void* d_ws, size_t ws_size, hipStream_t stream) {
    static int grid = 0;
    if (grid == 0) {
        if (n_in != 26 || out_size != M * DM || ws_size < WS_END) { fprintf(stderr, "kernel_launch: unexpected shapes: n_in %d out %d ws %zu\n", n_in, out_size, ws_size); grid = -1; return; }
        int dev = 0, cus = 0;
        if (hipGetDevice(&dev) != hipSuccess || hipDeviceGetAttribute(&cus, hipDeviceAttributeMultiprocessorCount, dev) != hipSuccess) { grid = -1; return; }
        (void)hipGetLastError();
        grid = cus;
    }
    if (grid < 0) return;
    (void)hipMemsetAsync((char*)d_ws + WS_CTL, 0, CTL_ZERO_BYTES, stream);
    Args a{};
    for (int i = 0; i < 26; ++i) a.in[i] = (const float*)d_in[i];
    a.out = (float*)d_out; a.ws = (unsigned char*)d_ws;
#if MK_LAUNCHES == 1
    launch_phases<0xFF, 0, NPHASE>(grid, a, stream);
#else
    launch_phases<0x01, 0, 1>(grid, a, stream);
    launch_phases<0x02, 1, 2>(grid, a, stream);
    launch_phases<0x04, 2, 3>(grid, a, stream);
    launch_phases<0x08, 3, 4>(grid, a, stream);
    launch_phases<0x10, 4, 5>(grid, a, stream);
    launch_phases<0x20, 5, 6>(grid, a, stream);
    launch_phases<0x40, 6, 7>(grid, a, stream);
    launch_phases<0x80, 7, 8>(grid, a, stream);
#endif
}
```

```cpp
#include <hip/hip_runtime.h>
#include <cstdio>
#include <cstdint>
namespace pg8 {
#define PG8_LAS __attribute__((address_space(3)))
typedef unsigned short bf16_t;
typedef short bf16x8 __attribute__((ext_vector_type(8)));
typedef float f32x4 __attribute__((ext_vector_type(4)));
typedef unsigned u32x4 __attribute__((ext_vector_type(4)));
constexpr int BM = 256, BK = 64, HALF = 128, HTB = HALF * BK * 2  , STAGE_BYTES = 8 * HTB, NXCD = 8, WGM = 8;

__host__ __device__ __forceinline__ int lds_byte(int r, int c) { const int st = (r >> 4) * 2 + (c >> 5), rr = r & 15, cc = c & 31, ob = rr * 64 + cc * 2; return st * 1024 + (ob ^ (((ob >> 9) & 1) << 5)); }
__host__ __device__ __forceinline__ void stage_rc(int b, int& R, int& C) { const int st = b / 1024, sb = b % 1024, swz = sb ^ (((sb >> 9) & 1) << 5); R = (st >> 1) * 16 + swz / 64; C = (st & 1) * 32 + (swz % 64) / 2; }
__host__ __device__ __forceinline__ int perm32(int rho) { const int n = rho >> 4, i = rho & 15; return 8 * (i >> 2) + 4 * n + (i & 3); }

struct Unit { int pm, pn; };
struct Gemm { const bf16_t* A; const bf16_t* Bt; int M, N, K; int a_rows = 256; };

struct StaticOrder {
    int nM, nN, nwg, G, c;
    __host__ __device__ void init(int M, int N, int G_, int c_) { nM = M / BM; nN = N / BM; nwg = nM * nN; G = G_; c = c_; }
    __host__ __device__ void init_tiles(int nM_, int nN_, int G_, int c_) { nM = nM_; nN = nN_; nwg = nM * nN; G = G_; c = c_; }
    __host__ __device__ bool next(int i, Unit& u) const {
        const long L = (long)i * G + c; if (L >= nwg) return false;
        int wgid = (int)L; { const int q = nwg / NXCD, r = nwg % NXCD, xcd = wgid % NXCD, off = wgid / NXCD; wgid = (xcd < r ? xcd * (q + 1) : r * (q + 1) + (xcd - r) * q) + off; }
        const int nig = WGM * nN, gid = wgid / nig, fm = gid * WGM, gsz = (nM - fm) < WGM ? (nM - fm) : WGM;
        u.pm = fm + ((wgid % nig) % gsz); u.pn = (wgid % nig) / gsz; return true;
    }
    __device__ __forceinline__ void a_ready(const Unit&) const {}
    __device__ __forceinline__ void done(const Unit&) const {}
};

__device__ __forceinline__ unsigned cvt_pk_bf16(float lo, float hi) { unsigned r; asm volatile("v_cvt_pk_bf16_f32 %0, %1, %2" : "=v"(r) : "v"(lo), "v"(hi)); return r; }
typedef float f32x2 __attribute__((ext_vector_type(2)));
__device__ __forceinline__ f32x2 gelu_pk(f32x2 v) {
    const f32x2 av = __builtin_elementwise_abs(v), d = av * 0.2316418882f + 1.0f;
    f32x2 t; t.x = __builtin_amdgcn_rcpf(d.x); t.y = __builtin_amdgcn_rcpf(d.y);
    f32x2 q = t * 0.5307027145f + (-0.7265760135f); q = q * t + 0.7107068705f; q = q * t + (-0.142248368f); q = q * t + 0.127414796f; q = q * t;
    const f32x2 s = (v * v) * (-0.72134752044f);
    f32x2 e; e.x = __builtin_amdgcn_exp2f(s.x); e.y = __builtin_amdgcn_exp2f(s.y);
    const f32x2 m = v * (q * e), r = v - m;
    f32x2 o; o.x = v.x < 0.f ? m.x : r.x; o.y = v.y < 0.f ? m.y : r.y; return o;
}

template <int ACT  > struct EpiBf16 {
    static constexpr bool PERM = true, AFTER_DRAIN = false; static_assert(ACT == 0 || ACT == 1, "EpiBf16: ACT is 0 (none) or 1 (gelu_pk)");
    bf16_t* O; int ldc; const float* bias; int split_cols; size_t split_stride; float scale0;
    __device__ __forceinline__ void operator()(const f32x4 (&acc)[2][2][4][2], const Unit& u, int wr, int wc, int fr, int fq) const {
        const int row0 = u.pm * BM + wr * 64 + fr; int colt = u.pn * BM; bf16_t* base = O;
        float sc = 1.f; if (split_cols) { const int t = colt / split_cols; base += (size_t)t * split_stride; colt -= t * split_cols; if (t == 0) sc = scale0; }
        const int col0 = colt + wc * 32 + 8 * fq, bcol0 = u.pn * BM + wc * 32 + 8 * fq;
        f32x4 bv[2][2];
#pragma unroll
        for (int bj = 0; bj < 2; ++bj)
#pragma unroll
            for (int n = 0; n < 2; ++n) bv[bj][n] = bias ? *(const f32x4*)(bias + bcol0 + bj * HALF + 4 * n) : (f32x4){0.f, 0.f, 0.f, 0.f};
#pragma unroll
        for (int ai = 0; ai < 2; ++ai)
#pragma unroll
            for (int m = 0; m < 4; ++m) { bf16_t* rowp = base + (size_t)(row0 + ai * HALF + m * 16) * ldc + col0;
#pragma unroll
                for (int bj = 0; bj < 2; ++bj) { f32x4 v0 = acc[ai][bj][m][0] + bv[bj][0], v1 = acc[ai][bj][m][1] + bv[bj][1];
                    if (ACT == 1) { f32x2 a = gelu_pk((f32x2){v0[0], v0[1]}), b = gelu_pk((f32x2){v0[2], v0[3]}), c = gelu_pk((f32x2){v1[0], v1[1]}), d = gelu_pk((f32x2){v1[2], v1[3]});
                        v0 = (f32x4){a.x, a.y, b.x, b.y}; v1 = (f32x4){c.x, c.y, d.x, d.y}; }
                    v0 = v0 * sc; v1 = v1 * sc; u32x4 w; w.x = cvt_pk_bf16(v0[0], v0[1]); w.y = cvt_pk_bf16(v0[2], v0[3]); w.z = cvt_pk_bf16(v1[0], v1[1]); w.w = cvt_pk_bf16(v1[2], v1[3]);
                    *(u32x4*)(rowp + bj * HALF) = w; } }
    }
};
template <class Epi, class Sched, bool ALIGN_EPI = false, bool SP2 = false>
__device__ __forceinline__ void gemm_phase(PG8_LAS unsigned char* lds, const Gemm g, const Sched& S, const Epi& E) {
    int tid_ = threadIdx.x; asm volatile("" : "+v"(tid_));
    const int tid = tid_, wid = __builtin_amdgcn_readfirstlane(tid >> 6), lane = tid & 63, wr = wid >> 2, wc = wid & 3, fr = lane & 15, fq = lane >> 4;
    const int K = g.K, nt = K / BK;
    unsigned voffA[2], voffB[2];
#pragma unroll
    for (int i = 0; i < 2; ++i) { int R, C; stage_rc(tid * 16 + i * 8192, R, C); const int Rb = Epi::PERM ? ((R & ~31) + perm32(R & 31)) : R;
        voffA[i] = (unsigned)(R * K + C) * 2u; voffB[i] = (unsigned)(Rb * K + C) * 2u; }
    const size_t kstep = (size_t)(BK * 2);
    const size_t hstep = (size_t)HALF * K * 2;
    const size_t tstep = 2 * hstep;
    const size_t astep = (size_t)g.a_rows * K * 2;
    const unsigned ldsw = (unsigned)wid * 1024u;
    const int aoff = lds_byte(wr * 64 + fr, fq * 8), boff = lds_byte(wc * 32 + fr, fq * 8);
#define PG8_SA(b, h) (((b) * 2 + (h)) * HTB)
#define PG8_SB(b, h) ((4 + (b) * 2 + (h)) * HTB)
#define PG8_STAGE(bufoff, gbase, voff) do { _Pragma("unroll") for (int _i = 0; _i < 2; ++_i) \
        __builtin_amdgcn_global_load_lds((const unsigned*)((const char*)(gbase) + (voff)[_i]), (PG8_LAS unsigned*)(lds + (bufoff) + ldsw + _i * 8192), 16, 0, 0); } while (0)
#define PG8_LDA(dst, b, h) do { _Pragma("unroll") for (int m = 0; m < 4; ++m) _Pragma("unroll") for (int k = 0; k < 2; ++k) dst[m][k] = *(const PG8_LAS bf16x8*)(lds + PG8_SA(b, h) + aoff + m * 2048 + k * 1024); } while (0)
#define PG8_LDB(dst, b, h) do { _Pragma("unroll") for (int n = 0; n < 2; ++n) _Pragma("unroll") for (int k = 0; k < 2; ++k) dst[n][k] = *(const PG8_LAS bf16x8*)(lds + PG8_SB(b, h) + boff + n * 2048 + k * 1024); } while (0)
#define PG8_MMA(ai, bj, At, Bt) do { __builtin_amdgcn_s_setprio(1); _Pragma("unroll") for (int m = 0; m < 4; ++m) _Pragma("unroll") for (int n = 0; n < 2; ++n) _Pragma("unroll") for (int k = 0; k < 2; ++k) \
        acc[ai][bj][m][n] = __builtin_amdgcn_mfma_f32_16x16x32_bf16(Bt[n][k], At[m][k], acc[ai][bj][m][n], 0, 0, 0); __builtin_amdgcn_s_setprio(0); } while (0)
#define PG8_WAIT_V(n) asm volatile("s_waitcnt vmcnt(" #n ")" ::: "memory")
#define PG8_WAIT_L(n) asm volatile("s_waitcnt lgkmcnt(" #n ")" ::: "memory")
#define PG8_BAR __builtin_amdgcn_s_barrier()
#define PG8_SCHED __builtin_amdgcn_sched_barrier(0)
    Unit cur, nxt; int ui = 0;
    if (!S.next(0, cur)) return;
    f32x4 acc[2][2][4][2];
#pragma unroll
    for (int a = 0; a < 2; ++a)
#pragma unroll
        for (int b = 0; b < 2; ++b)
#pragma unroll
            for (int m = 0; m < 4; ++m)
#pragma unroll
                for (int n = 0; n < 2; ++n) acc[a][b][m][n] = (f32x4){0.f, 0.f, 0.f, 0.f};
    bf16x8 At[4][2], B0[2][2], B1[2][2];
    const char* cA = (const char*)g.A + (size_t)cur.pm * astep; const char* cB = (const char*)g.Bt + (size_t)cur.pn * tstep;
    S.a_ready(cur);
    if constexpr (SP2) {
        PG8_STAGE(PG8_SB(0, 0), cB, voffB); PG8_STAGE(PG8_SB(0, 1), cB + hstep, voffB); PG8_STAGE(PG8_SA(0, 0), cA, voffA); PG8_STAGE(PG8_SA(0, 1), cA + hstep, voffA);
        if (wr == 1) PG8_BAR;
        PG8_WAIT_V(2); PG8_BAR;
        PG8_STAGE(PG8_SB(1, 0), cB + kstep, voffB); PG8_STAGE(PG8_SA(1, 0), cA + kstep, voffA); PG8_STAGE(PG8_SB(1, 1), cB + hstep + kstep, voffB);
        PG8_WAIT_V(6); PG8_BAR;
    } else {
        PG8_STAGE(PG8_SB(0, 0), cB, voffB); PG8_STAGE(PG8_SA(0, 0), cA, voffA); PG8_STAGE(PG8_SB(0, 1), cB + hstep, voffB); PG8_STAGE(PG8_SA(0, 1), cA + hstep, voffA);
        if (wr == 1) PG8_BAR;
        PG8_WAIT_V(4); PG8_BAR;
        PG8_STAGE(PG8_SB(1, 0), cB + kstep, voffB); PG8_STAGE(PG8_SA(1, 0), cA + kstep, voffA); PG8_STAGE(PG8_SB(1, 1), cB + hstep + kstep, voffB);
        PG8_WAIT_V(6); PG8_BAR;
    }
    for (;;) {
        const bool has_next = S.next(ui + 1, nxt);
        const char* nA = has_next ? (const char*)g.A + (size_t)nxt.pm * astep : cA; const char* nB = has_next ? (const char*)g.Bt + (size_t)nxt.pn * tstep : cB;
        for (int t = 0; t < nt; t += 2) {
            const bool last = (t == nt - 2);
            const char* a1 = cA + (size_t)(t + 1) * kstep;
            const char* a2 = last ? nA : cA + (size_t)(t + 2) * kstep; const char* b2 = last ? nB : cB + (size_t)(t + 2) * kstep;
            const char* a3 = a2 + kstep; const char* b3 = b2 + kstep;
            if (last && has_next) S.a_ready(nxt);
            if constexpr (SP2) {
            PG8_LDB(B0, 0, 0); PG8_LDB(B1, 0, 1); PG8_SCHED; PG8_LDA(At, 0, 0); PG8_STAGE(PG8_SA(1, 1), a1 + hstep, voffA);
            PG8_WAIT_V(8); PG8_WAIT_L(0); PG8_BAR; PG8_MMA(0, 0, At, B0); PG8_MMA(0, 1, At, B1); PG8_BAR; PG8_SCHED;
            PG8_LDA(At, 0, 1); PG8_STAGE(PG8_SB(0, 0), b2, voffB); PG8_STAGE(PG8_SB(0, 1), b2 + hstep, voffB); PG8_STAGE(PG8_SA(0, 0), a2, voffA);
            PG8_WAIT_V(8); PG8_WAIT_L(0); PG8_BAR; PG8_MMA(1, 0, At, B0); PG8_MMA(1, 1, At, B1); PG8_BAR; PG8_SCHED;
            PG8_LDB(B0, 1, 0); PG8_LDB(B1, 1, 1); PG8_SCHED; PG8_LDA(At, 1, 0); PG8_STAGE(PG8_SA(0, 1), a2 + hstep, voffA);
            PG8_WAIT_V(8); PG8_WAIT_L(0); PG8_BAR; PG8_MMA(0, 0, At, B0); PG8_MMA(0, 1, At, B1); PG8_BAR; PG8_SCHED;
            PG8_LDA(At, 1, 1); PG8_STAGE(PG8_SB(1, 0), b3, voffB); PG8_STAGE(PG8_SB(1, 1), b3 + hstep, voffB); PG8_STAGE(PG8_SA(1, 0), a3, voffA);
            PG8_WAIT_V(8); PG8_WAIT_L(0); PG8_BAR; PG8_MMA(1, 0, At, B0); PG8_MMA(1, 1, At, B1); PG8_BAR; PG8_SCHED;
            } else {
            PG8_LDB(B0, 0, 0); PG8_SCHED; PG8_LDA(At, 0, 0); PG8_STAGE(PG8_SA(1, 1), a1 + hstep, voffA);
            PG8_WAIT_L(8); PG8_BAR; PG8_WAIT_L(0); PG8_MMA(0, 0, At, B0); PG8_BAR; PG8_SCHED;
            PG8_LDB(B1, 0, 1); PG8_STAGE(PG8_SB(0, 0), b2, voffB);
            PG8_BAR; PG8_WAIT_L(0); PG8_MMA(0, 1, At, B1); PG8_BAR;
            PG8_LDA(At, 0, 1); PG8_STAGE(PG8_SA(0, 0), a2, voffA);
            PG8_BAR; PG8_WAIT_L(0); PG8_MMA(1, 0, At, B0); PG8_BAR; PG8_SCHED;
            PG8_STAGE(PG8_SB(0, 1), b2 + hstep, voffB);
            PG8_WAIT_V(6); PG8_BAR; PG8_MMA(1, 1, At, B1); PG8_BAR;
            PG8_LDB(B0, 1, 0); PG8_SCHED; PG8_LDA(At, 1, 0); PG8_STAGE(PG8_SA(0, 1), a2 + hstep, voffA);
            PG8_WAIT_L(8); PG8_BAR; PG8_WAIT_L(0); PG8_MMA(0, 0, At, B0); PG8_BAR; PG8_SCHED;
            PG8_LDB(B1, 1, 1); PG8_STAGE(PG8_SB(1, 0), b3, voffB);
            PG8_BAR; PG8_WAIT_L(0); PG8_MMA(0, 1, At, B1); PG8_BAR;
            PG8_LDA(At, 1, 1); PG8_STAGE(PG8_SA(1, 0), a3, voffA);
            PG8_BAR; PG8_WAIT_L(0); PG8_MMA(1, 0, At, B0); PG8_BAR; PG8_SCHED;
            PG8_STAGE(PG8_SB(1, 1), b3 + hstep, voffB);
            PG8_WAIT_V(6); PG8_BAR; PG8_MMA(1, 1, At, B1); PG8_BAR;
            }
        }
        if constexpr (ALIGN_EPI) { if (wr == 0) PG8_BAR; }
        if constexpr (!Epi::AFTER_DRAIN) { E(acc, cur, wr, wc, fr, fq); S.done(cur); }
        if (!has_next) break;
#pragma unroll
        for (int a = 0; a < 2; ++a)
#pragma unroll
            for (int b = 0; b < 2; ++b)
#pragma unroll
                for (int m = 0; m < 4; ++m)
#pragma unroll
                    for (int n = 0; n < 2; ++n) acc[a][b][m][n] = (f32x4){0.f, 0.f, 0.f, 0.f};
        cur = nxt; cA = nA; cB = nB; ++ui;
        if constexpr (ALIGN_EPI) { if (wr == 1) PG8_BAR; }
    }
    PG8_WAIT_V(0);
    if constexpr (!ALIGN_EPI) { if (wr == 0) PG8_BAR; }
    PG8_BAR;
    if constexpr (Epi::AFTER_DRAIN) { E.fused(acc, cur, wr, wc, fr, fq, lds, wid, lane); S.done(cur); }
#undef PG8_SA
#undef PG8_SB
#undef PG8_STAGE
#undef PG8_LDA
#undef PG8_LDB
#undef PG8_MMA
#undef PG8_WAIT_V
#undef PG8_WAIT_L
#undef PG8_BAR
#undef PG8_SCHED
}
}

#ifndef PG8_SP2
#define PG8_SP2 true
#endif
#ifndef PG8_ALIGN
#define PG8_ALIGN true
#endif

constexpr int NWAVES = 8;
constexpr int BATCH = 2, SEQ = 8192, DM = 2048, M = BATCH * SEQ;
constexpr int DA = 1024, DB = 1024, NHA = 8, DIN = 5120, DFF = 5504, NUP = 2 * DFF;
constexpr float EPS = 1e-6f;
constexpr int FORD = 64;

constexpr size_t MiB = 1u << 20;
constexpr size_t WS_CTL = 0, CTL_ZERO_BYTES = 65536;
constexpr size_t WS_SS = 1 * MiB;
constexpr size_t WS_WIN = 2 * MiB, WS_WOUT = 22 * MiB, WS_WUP = 30 * MiB, WS_WDN = 73 * MiB;
constexpr size_t WS_XN1 = 96 * MiB, WS_ZU = 160 * MiB, WS_ZVT = 192 * MiB, WS_BINT = 224 * MiB;
constexpr size_t WS_H3 = 320 * MiB, WS_HT = 322 * MiB, WS_YBT = 386 * MiB, WS_MRG = 418 * MiB;
constexpr size_t WS_H = 96 * MiB;
constexpr size_t WS_XB2 = 269 * MiB;
constexpr size_t WS_GVH = 336 * MiB;
constexpr size_t WS_KBUF = 96 * MiB;
constexpr size_t WS_DUMOUT = 336 * MiB;
constexpr size_t WS_END = 508 * MiB;
constexpr int CW_TMO = 0, CW_CODE = 1, CW_BAR = 4096;

constexpr int RING_OFF = 0, RING_BYTES = 131072;
constexpr int LDS_BYTES = 163840;
constexpr int LDSCTL_OFF = LDS_BYTES - 1024, MISC_OFF = LDSCTL_OFF + 320;
constexpr int RED_OFF = MISC_OFF + 128;
static_assert(RED_OFF + 256 <= LDS_BYTES, "LDS map");

#define GAS __attribute__((address_space(1)))
#define LAS __attribute__((address_space(3)))
typedef unsigned short bf16;
typedef unsigned v4u __attribute__((ext_vector_type(4)));
typedef float f32x4 __attribute__((ext_vector_type(4)));
typedef short bf16x8 __attribute__((ext_vector_type(8)));
typedef GAS unsigned gu32;
typedef GAS unsigned long long gu64;
#define RLX_AGENT __ATOMIC_RELAXED, __HIP_MEMORY_SCOPE_AGENT
#define LDS_WAIT() asm volatile("s_waitcnt lgkmcnt(0)" ::: "memory")
#define VM_WAIT() asm volatile("s_waitcnt vmcnt(0)" ::: "memory")
__device__ __forceinline__ unsigned long long rt() { return __builtin_amdgcn_s_memrealtime(); }
__device__ __forceinline__ unsigned f2bf(float f) { unsigned u = __builtin_bit_cast(unsigned, f); return (u + 0x7fffu + ((u >> 16) & 1u)) >> 16; }
__device__ __forceinline__ unsigned pk2(float lo, float hi) { return f2bf(lo) | (f2bf(hi) << 16); }

#define XB_TMO      128
#define XB_XCNT(j)  (256  + 64 * (j))
#define XB_XSUB(j)  (1280 + 64 * (j))
#define XB_XGEN(j)  (2304 + 64 * (j))
#define XB_TOP      3328
#define XB_TOPGEN   3392
#define XCD_BAR_WORDS 3456
#define XB_SPIN_CAP (1u << 18)

__device__ __forceinline__ unsigned xb_ld(unsigned* p)              { return __hip_atomic_load(p, __ATOMIC_RELAXED, __HIP_MEMORY_SCOPE_AGENT); }
__device__ __forceinline__ unsigned xb_add(unsigned* p, unsigned v) { return __hip_atomic_fetch_add(p, v, __ATOMIC_RELAXED, __HIP_MEMORY_SCOPE_AGENT); }
__device__ __forceinline__ unsigned xb_xcc_id() { return (unsigned)__builtin_amdgcn_s_getreg((3 << 11) | 20) & 0xFu; }
#define XB_SPIN(cond, bar) do { unsigned _sp = 0; while (cond) { __builtin_amdgcn_s_sleep(1); \
    if ((++_sp & 255u) == 0u) { if (xb_ld(&(bar)[XB_TMO])) break; if (_sp > XB_SPIN_CAP) { atomicAdd(&(bar)[XB_TMO], 1u); break; } } } } while (0)

struct XcdBarrier {
    unsigned* bar; unsigned x;
    volatile LAS unsigned* st;
};

__device__ __forceinline__ XcdBarrier xcd_barrier_post(unsigned* bar, volatile LAS unsigned* st) {
    XcdBarrier b; b.bar = bar; b.x = xb_xcc_id(); b.st = st;
    if (threadIdx.x == 0) (void)xb_add(&bar[XB_XCNT(b.x)], 1u);
    return b;
}
__device__ __forceinline__ void xcd_barrier_complete(unsigned* bar, unsigned x, unsigned& nloc, unsigned& nx) {
    const unsigned G = gridDim.x * gridDim.y * gridDim.z;
    unsigned sum, cnt, mine, sp = 0u;
    for (;;) {
        sum = 0u; cnt = 0u; mine = 0u;
#pragma unroll
        for (unsigned j = 0; j < 16; ++j) { const unsigned c = xb_ld(&bar[XB_XCNT(j)]); sum += c; cnt += (c > 0u) ? 1u : 0u; mine = (j == x) ? c : mine; }
        if (sum == G) break;
        __builtin_amdgcn_s_sleep(1);
        if ((++sp & 255u) == 0u) { if (xb_ld(&bar[XB_TMO])) break; if (sp > XB_SPIN_CAP) { atomicAdd(&bar[XB_TMO], 1u); break; } }
    }
    nloc = mine > 0u ? mine : 1u; nx = cnt > 0u ? cnt : 1u;
}

__device__ __forceinline__ void xcd_barrier(const XcdBarrier& b) {
    asm volatile("s_waitcnt vmcnt(0)" ::: "memory");
    __syncthreads();
    if (threadIdx.x == 0) {
        unsigned* bar = b.bar;
        __builtin_amdgcn_s_waitcnt(0);
        unsigned nloc = b.st[0], nx = b.st[1];
        if (nloc == 0u) { xcd_barrier_complete(bar, b.x, nloc, nx); b.st[0] = nloc; b.st[1] = nx; }
        const unsigned old = xb_add(&bar[XB_XSUB(b.x)], 1u);
        const unsigned gen = old / nloc;
        if (old + 1u == (gen + 1u) * nloc) {
            __builtin_amdgcn_fence(__ATOMIC_RELEASE, "agent");
            asm volatile("s_waitcnt vmcnt(0)" ::: "memory");
            const unsigned og = xb_add(&bar[XB_TOP], 1u);
            const unsigned tg = og / nx;
            if (og + 1u == (tg + 1u) * nx) xb_add(&bar[XB_TOPGEN], 1u);
            else XB_SPIN(xb_ld(&bar[XB_TOPGEN]) == tg, bar);
            __builtin_amdgcn_fence(__ATOMIC_ACQUIRE, "agent");
            xb_add(&bar[XB_XGEN(b.x)], 1u);
            asm volatile("s_waitcnt vmcnt(0)" ::: "memory");
        } else {
            XB_SPIN(xb_ld(&bar[XB_XGEN(b.x)]) == gen, bar);
            __builtin_amdgcn_fence(__ATOMIC_ACQUIRE, "agent");
            asm volatile("s_waitcnt vmcnt(0)" ::: "memory");
        }
    }
    __syncthreads();
}
#ifndef FFT_HD
#define FFT_HD __device__ __forceinline__
#define FFT_LDS __attribute__((address_space(3)))
#endif
#if defined(__clang__)
typedef float cpx __attribute__((ext_vector_type(2)));
#else
struct cpx { float x, y; };
#endif
#if defined(__HIP_DEVICE_COMPILE__)
FFT_HD float f_add(float a, float b) { float r; asm("v_add_f32_e32 %0, %1, %2" : "=v"(r) : "v"(a), "v"(b)); return r; }
FFT_HD float f_sub(float a, float b) { float r; asm("v_sub_f32_e32 %0, %1, %2" : "=v"(r) : "v"(a), "v"(b)); return r; }
FFT_HD float f_mul(float a, float b) { float r; asm("v_mul_f32_e32 %0, %1, %2" : "=v"(r) : "v"(a), "v"(b)); return r; }
FFT_HD float f_fma(float a, float b, float c) { float r; asm("v_fma_f32 %0, %1, %2, %3" : "=v"(r) : "v"(a), "v"(b), "v"(c)); return r; }
FFT_HD float f_fnma(float a, float b, float c) { float r; asm("v_fma_f32 %0, -%1, %2, %3" : "=v"(r) : "v"(a), "v"(b), "v"(c)); return r; }
#else
FFT_HD float f_add(float a, float b) { return a + b; }
FFT_HD float f_sub(float a, float b) { return a - b; }
FFT_HD float f_mul(float a, float b) { return a * b; }
FFT_HD float f_fma(float a, float b, float c) { return a * b + c; }
FFT_HD float f_fnma(float a, float b, float c) { return c - a * b; }
#endif
FFT_HD cpx c_add(cpx a, cpx b) { return cpx{f_add(a.x, b.x), f_add(a.y, b.y)}; }
FFT_HD cpx c_sub(cpx a, cpx b) { return cpx{f_sub(a.x, b.x), f_sub(a.y, b.y)}; }
FFT_HD cpx c_mul(cpx a, cpx b) { return cpx{f_fnma(a.y, b.y, f_mul(a.x, b.x)), f_fma(a.y, b.x, f_mul(a.x, b.y))}; }
constexpr int FFT_N = 16384, FFT_PHYS = FFT_N + (FFT_N >> 6) * 4;
FFT_HD int fft_p(int i) { return i + ((i >> 6) << 2); }

template <bool INV> FFT_HD void dft4(cpx& a0, cpx& a1, cpx& a2, cpx& a3) {
    const cpx s02 = c_add(a0, a2), d02 = c_sub(a0, a2), s13 = c_add(a1, a3), d13 = c_sub(a1, a3);
    a0 = c_add(s02, s13); a2 = c_sub(s02, s13);
    if (!INV) { a1 = cpx{f_add(d02.x, d13.y), f_sub(d02.y, d13.x)}; a3 = cpx{f_sub(d02.x, d13.y), f_add(d02.y, d13.x)}; }
    else      { a1 = cpx{f_sub(d02.x, d13.y), f_add(d02.y, d13.x)}; a3 = cpx{f_add(d02.x, d13.y), f_sub(d02.y, d13.x)}; }
}
FFT_HD cpx c_mulk(cpx a, float c, float s) { return cpx{f_fnma(a.y, s, f_mul(a.x, c)), f_fma(a.y, c, f_mul(a.x, s))}; }
template <bool INV> FFT_HD void dft16(cpx (&a)[16]) {
#pragma unroll
    for (int mb = 0; mb < 4; ++mb) dft4<INV>(a[mb], a[mb + 4], a[mb + 8], a[mb + 12]);
    const float C1 = 0.92387953251128674f, S1 = 0.38268343236508977f, R2 = 0.70710678118654752f;
    const float sg = INV ? 1.0f : -1.0f;
    a[5] = c_mulk(a[5], C1, sg * S1);
    a[6] = c_mulk(a[6], R2, sg * R2);
    a[7] = c_mulk(a[7], S1, sg * C1);
    a[9] = c_mulk(a[9], R2, sg * R2);
    a[10] = INV ? cpx{-a[10].y, a[10].x} : cpx{a[10].y, -a[10].x};
    a[11] = c_mulk(a[11], -R2, sg * R2);
    a[13] = c_mulk(a[13], S1, sg * C1);
    a[14] = c_mulk(a[14], -R2, sg * R2);
    a[15] = c_mulk(a[15], -C1, -sg * S1);
#pragma unroll
    for (int qa = 0; qa < 4; ++qa) dft4<INV>(a[4 * qa], a[4 * qa + 1], a[4 * qa + 2], a[4 * qa + 3]);
}
FFT_HD void fft_sincos(float frac, float& s, float& c) {
#if defined(__HIP_DEVICE_COMPILE__)
    s = __builtin_amdgcn_sinf(frac); c = __builtin_amdgcn_cosf(frac);
#else
    s = (float)sin(6.283185307179586 * (double)frac); c = (float)cos(6.283185307179586 * (double)frac);
#endif
}
template <bool INV, int S> FFT_HD void fft_pass16(FFT_LDS cpx* X, int b) {
    constexpr int n = 16 * S;
    constexpr int PS = (S >= 64) ? S + (S >> 4) : S;
    const int blk = b / S, j = b % S, base = blk * n + j;
    FFT_LDS cpx* xp = X + fft_p(base);
    cpx a[16];
    cpx w[16];
    { float sn, cs; fft_sincos((float)j / (float)n, sn, cs); w[1] = cpx{cs, INV ? sn : -sn};
      w[2] = c_mul(w[1], w[1]); w[3] = c_mul(w[2], w[1]); w[4] = c_mul(w[2], w[2]); w[5] = c_mul(w[4], w[1]); w[6] = c_mul(w[3], w[3]); w[7] = c_mul(w[4], w[3]);
      w[8] = c_mul(w[4], w[4]); w[9] = c_mul(w[8], w[1]); w[10] = c_mul(w[5], w[5]); w[11] = c_mul(w[8], w[3]); w[12] = c_mul(w[6], w[6]); w[13] = c_mul(w[8], w[5]);
      w[14] = c_mul(w[7], w[7]); w[15] = c_mul(w[8], w[7]); }
    if (!INV) {
#pragma unroll
        for (int m = 0; m < 16; ++m) a[m] = xp[PS * m];
        dft16<false>(a);
#pragma unroll
        for (int q = 0; q < 16; ++q) { cpx v = a[4 * (q & 3) + (q >> 2)]; if (q) v = c_mul(v, w[q]); xp[PS * q] = v; }
    } else {
#pragma unroll
        for (int q = 0; q < 16; ++q) { cpx v = xp[PS * q]; if (q) v = c_mul(v, w[q]); a[q] = v; }
        dft16<true>(a);
#pragma unroll
        for (int m = 0; m < 16; ++m) xp[PS * m] = a[4 * (m & 3) + (m >> 2)];
    }
}
template <bool INV> FFT_HD void fft_pass4(FFT_LDS cpx* X, int b) {
    const int p = fft_p(4 * b);
    cpx a0 = X[p], a1 = X[p + 1], a2 = X[p + 2], a3 = X[p + 3];
    dft4<INV>(a0, a1, a2, a3);
    X[p] = a0; X[p + 1] = a1; X[p + 2] = a2; X[p + 3] = a3;
}

typedef unsigned u32x2 __attribute__((ext_vector_type(2)));
struct Frame {
    LAS unsigned char* lds;
    volatile LAS unsigned* MISC;
    gu32* ctl;
    int tid, lane, wave;
    int vcu, G;
    const float *x, *norm1_g, *w_in, *sgu_norm_g, *sgu_w, *sgu_b, *hy_conv_w, *hy_conv_b;
    const float *f_w1, *f_b1, *f_w2, *f_b2, *f_w3, *f_b3, *f_freq, *f_wout, *d_skip;
    const float *on_a_g, *on_b_g, *w_out, *norm2_g, *w_up, *dw_w, *dw_b, *w_down, *final_g;
    float* out;
    float *ssv, *ssa, *ss2, *ss3, *h3, *hT, *dum_ss, *dum_out;
    bf16 *Wt_in, *Wt_out, *Wt_up, *Wt_dn, *xn1, *zu, *zvT, *binT, *ybT, *mrg, *hb, *xb2;
};
struct Args { const float* in[26]; float* out; unsigned char* ws; int ph_lo, ph_hi, li, pad; };
typedef const __attribute__((address_space(4))) Args* CArgsP;
__device__ __forceinline__ CArgsP kargs() {
    CArgsP p = (CArgsP)__builtin_amdgcn_kernarg_segment_ptr();
    asm volatile("" : "+s"(p));
    return p;
}
__device__ __forceinline__ void frame_ptrs(Frame& F) {
    extern __shared__ __attribute__((aligned(16))) unsigned char lds_dyn[];
    F.lds = (LAS unsigned char*)lds_dyn;
    F.MISC = (volatile LAS unsigned*)(F.lds + MISC_OFF);
    int tid_ = threadIdx.x; asm volatile("" : "+v"(tid_));
    F.tid = tid_; F.lane = F.tid & 63; F.wave = __builtin_amdgcn_readfirstlane(F.tid >> 6);
    int g_ = gridDim.x, bx_ = blockIdx.x; asm volatile("" : "+s"(g_), "+s"(bx_));
    F.G = g_; F.vcu = (F.G % 8 == 0) ? (bx_ % 8) * (F.G / 8) + bx_ / 8 : bx_;
    CArgsP A = kargs();
    unsigned char* ws = A->ws;
    F.ctl = (gu32*)(ws + WS_CTL);
    F.x = A->in[0]; F.norm1_g = A->in[1]; F.w_in = A->in[2]; F.sgu_norm_g = A->in[3]; F.sgu_w = A->in[4]; F.sgu_b = A->in[5];
    F.hy_conv_w = A->in[6]; F.hy_conv_b = A->in[7]; F.f_w1 = A->in[8]; F.f_b1 = A->in[9]; F.f_w2 = A->in[10]; F.f_b2 = A->in[11];
    F.f_w3 = A->in[12]; F.f_b3 = A->in[13]; F.f_freq = A->in[14]; F.f_wout = A->in[15]; F.d_skip = A->in[16];
    F.on_a_g = A->in[17]; F.on_b_g = A->in[18]; F.w_out = A->in[19]; F.norm2_g = A->in[20]; F.w_up = A->in[21];
    F.dw_w = A->in[22]; F.dw_b = A->in[23]; F.w_down = A->in[24]; F.final_g = A->in[25]; F.out = A->out;
    F.ssv = (float*)(ws + WS_SS); F.ssa = F.ssv + M; F.ss2 = F.ssa + M; F.ss3 = F.ss2 + M;
    F.h3 = (float*)(ws + WS_H3); F.hT = (float*)(ws + WS_HT); F.dum_ss = F.ssv + 4 * M; F.dum_out = (float*)(ws + WS_DUMOUT);
    F.Wt_in = (bf16*)(ws + WS_WIN); F.Wt_out = (bf16*)(ws + WS_WOUT); F.Wt_up = (bf16*)(ws + WS_WUP); F.Wt_dn = (bf16*)(ws + WS_WDN);
    F.xn1 = (bf16*)(ws + WS_XN1); F.zu = (bf16*)(ws + WS_ZU); F.zvT = (bf16*)(ws + WS_ZVT); F.binT = (bf16*)(ws + WS_BINT);
    F.ybT = (bf16*)(ws + WS_YBT); F.mrg = (bf16*)(ws + WS_MRG); F.hb = (bf16*)(ws + WS_H); F.xb2 = (bf16*)(ws + WS_XB2);
}


__device__ __forceinline__ float wave_sum(float v) {
#pragma unroll
    for (int o = 1; o < 64; o <<= 1) v += __shfl_xor(v, o);
    return v;
}
__device__ __forceinline__ float bf2f(unsigned short b) { return __builtin_bit_cast(float, ((unsigned)b) << 16); }
__device__ __forceinline__ float bflo(unsigned w) { return __builtin_bit_cast(float, w << 16); }
__device__ __forceinline__ float bfhi(unsigned w) { return __builtin_bit_cast(float, w & 0xffff0000u); }
__device__ __forceinline__ float gelu_f(float v) { return 0.5f * v * (1.0f + erff(v * 0.70710678118654752f)); }
__device__ __forceinline__ float rsq(float v) { return 1.0f / sqrtf(v); }

namespace pg8 {
struct Epi1b {
    static constexpr bool PERM = true, AFTER_DRAIN = false;
    bf16_t* zvT; bf16_t* binT; const float* g_sgu; float* ssv;
    __device__ __forceinline__ void operator()(const f32x4 (&acc)[2][2][4][2], const Unit& u, int wr, int wc, int fr, int fq) const {
        const int row0 = u.pm * BM + wr * 64 + fr, col0 = u.pn * BM + wc * 32 + 8 * fq;
        if (u.pm < 4) {
            float ss[2][8];
#pragma unroll
            for (int bj = 0; bj < 2; ++bj)
#pragma unroll
                for (int k = 0; k < 8; ++k) ss[bj][k] = 0.f;
#pragma unroll
            for (int ai = 0; ai < 2; ++ai)
#pragma unroll
                for (int m = 0; m < 4; ++m) { const int r = row0 + ai * HALF + m * 16; const float gg = g_sgu[r]; bf16_t* rowp = zvT + (size_t)r * 16384 + col0;
#pragma unroll
                    for (int bj = 0; bj < 2; ++bj) { const f32x4 v0 = acc[ai][bj][m][0], v1 = acc[ai][bj][m][1];
                        const f32x2 a = gelu_pk((f32x2){v0[0], v0[1]}), b = gelu_pk((f32x2){v0[2], v0[3]}), c = gelu_pk((f32x2){v1[0], v1[1]}), d = gelu_pk((f32x2){v1[2], v1[3]});
                        ss[bj][0] += a.x * a.x; ss[bj][1] += a.y * a.y; ss[bj][2] += b.x * b.x; ss[bj][3] += b.y * b.y;
                        ss[bj][4] += c.x * c.x; ss[bj][5] += c.y * c.y; ss[bj][6] += d.x * d.x; ss[bj][7] += d.y * d.y;
                        u32x4 w; w.x = cvt_pk_bf16(a.x * gg, a.y * gg); w.y = cvt_pk_bf16(b.x * gg, b.y * gg); w.z = cvt_pk_bf16(c.x * gg, c.y * gg); w.w = cvt_pk_bf16(d.x * gg, d.y * gg);
                        *(u32x4*)(rowp + bj * HALF) = w; } }
#pragma unroll
            for (int bj = 0; bj < 2; ++bj)
#pragma unroll
                for (int k = 0; k < 8; ++k) { float v = ss[bj][k]; v += __shfl_xor(v, 1); v += __shfl_xor(v, 2); v += __shfl_xor(v, 4); v += __shfl_xor(v, 8);
                    if (fr == 0) atomicAdd(ssv + col0 + bj * HALF + k, v); }
        } else {
#pragma unroll
            for (int ai = 0; ai < 2; ++ai)
#pragma unroll
                for (int m = 0; m < 4; ++m) { const int r = row0 + ai * HALF + m * 16 - 1024; bf16_t* rowp = binT + (size_t)r * 16384 + col0;
#pragma unroll
                    for (int bj = 0; bj < 2; ++bj) { const f32x4 v0 = acc[ai][bj][m][0], v1 = acc[ai][bj][m][1];
                        u32x4 w; w.x = cvt_pk_bf16(v0[0], v0[1]); w.y = cvt_pk_bf16(v0[2], v0[3]); w.z = cvt_pk_bf16(v1[0], v1[1]); w.w = cvt_pk_bf16(v1[2], v1[3]);
                        *(u32x4*)(rowp + bj * HALF) = w; } }
        }
    }
};
struct Epi2 {
    static constexpr bool PERM = true, AFTER_DRAIN = false;
    const float* x; bf16_t* xb2; const float* ssa; float* ss2;
    __device__ __forceinline__ void operator()(const f32x4 (&acc)[2][2][4][2], const Unit& u, int wr, int wc, int fr, int fq) const {
        const int row0 = u.pm * BM + wr * 64 + fr, col0 = u.pn * BM + wc * 32 + 8 * fq;
#pragma unroll
        for (int ai = 0; ai < 2; ++ai) {
            f32x4 xv[4][2][2]; float ra[4];
#pragma unroll
            for (int m = 0; m < 4; ++m) { const int r = row0 + ai * HALF + m * 16; const size_t off = (size_t)r * 2048 + col0; ra[m] = ssa[r];
#pragma unroll
                for (int bj = 0; bj < 2; ++bj) { xv[m][bj][0] = *(const f32x4*)(x + off + bj * HALF); xv[m][bj][1] = *(const f32x4*)(x + off + bj * HALF + 4); } }
#pragma unroll
            for (int m = 0; m < 4; ++m) { const int r = row0 + ai * HALF + m * 16; const float rr = 1.0f / sqrtf(ra[m] * (1.0f / 1024.0f) + 1e-6f); float s = 0.f;
                const size_t off = (size_t)r * 2048 + col0;
#pragma unroll
                for (int bj = 0; bj < 2; ++bj) { const f32x4 v0 = xv[m][bj][0] + acc[ai][bj][m][0] * rr, v1 = xv[m][bj][1] + acc[ai][bj][m][1] * rr;
                    s += (v0[0] * v0[0] + v0[1] * v0[1]) + (v0[2] * v0[2] + v0[3] * v0[3]) + (v1[0] * v1[0] + v1[1] * v1[1]) + (v1[2] * v1[2] + v1[3] * v1[3]);
                    u32x4 w; w.x = cvt_pk_bf16(v0[0], v0[1]); w.y = cvt_pk_bf16(v0[2], v0[3]); w.z = cvt_pk_bf16(v1[0], v1[1]); w.w = cvt_pk_bf16(v1[2], v1[3]);
                    *(u32x4*)(xb2 + off + bj * HALF) = w; }
                s += __shfl_xor(s, 16); s += __shfl_xor(s, 32);
                if (fq == 0) atomicAdd(ss2 + r, s); }
            asm volatile("" ::: "memory"); }
    }
};
struct Epi3 {
    static constexpr bool PERM = true, AFTER_DRAIN = false;
    bf16_t* h; const float* ss2; const float* dw_w; const float* dw_b; PG8_LAS float* E;
    __device__ __forceinline__ void operator()(const f32x4 (&acc)[2][2][4][2], const Unit& u, int wr, int wc, int fr, int fq) const {
        const int lane = fq * 16 + fr, lprev = (lane & 48) | ((lane - 1) & 15), lnext = (lane & 48) | ((lane + 1) & 15);
        const int chl = wc * 32 + 8 * fq, ch = u.pn * 128 + chl, rowbase = u.pm * 254 - 1;
        const int tid = (wr * 4 + wc) * 64 + lane;
        if (tid < 256) { const int arr = tid >> 6, c2 = (tid & 63) * 2; const f32x2 v = (arr < 3) ? *(const f32x2*)(dw_w + arr * 5504 + u.pn * 128 + c2) : *(const f32x2*)(dw_b + u.pn * 128 + c2);
               *(PG8_LAS f32x2*)(E + 1280 + arr * 128 + c2) = v; }
        float r2[2][4];
#pragma unroll
        for (int ai = 0; ai < 2; ++ai)
#pragma unroll
            for (int m = 0; m < 4; ++m) { const int tg = rowbase + ai * HALF + wr * 64 + m * 16 + fr; r2[ai][m] = (tg >= 0 && tg < 16384) ? 1.0f / sqrtf(ss2[tg] * (1.0f / 2048.0f) + 1e-6f) : 0.f; }
#pragma unroll
        for (int ai = 0; ai < 2; ++ai) { const int kb = 2 * ai + wr;
            if (fr == 0) { *(PG8_LAS f32x4*)(E + kb * 128 + chl) = acc[ai][0][0][0] * r2[ai][0]; *(PG8_LAS f32x4*)(E + kb * 128 + chl + 4) = acc[ai][0][0][1] * r2[ai][0]; }
            if (fr == 15) { *(PG8_LAS f32x4*)(E + 512 + kb * 128 + chl) = acc[ai][0][3][0] * r2[ai][3]; *(PG8_LAS f32x4*)(E + 512 + kb * 128 + chl + 4) = acc[ai][0][3][1] * r2[ai][3]; } }
        asm volatile("s_waitcnt lgkmcnt(0)" ::: "memory"); __builtin_amdgcn_s_barrier(); asm volatile("" ::: "memory");
#pragma unroll
        for (int ai = 0; ai < 2; ++ai) { const int kb = 2 * ai + wr;
            unsigned pk[4][4];
            bool pz[4], nz[4];
#pragma unroll
            for (int m = 0; m < 4; ++m) { const int tg = rowbase + ai * HALF + wr * 64 + m * 16 + fr; pz[m] = (tg & 8191) == 0; nz[m] = (tg & 8191) == 8191; }
#pragma unroll
            for (int n = 0; n < 2; ++n)
#pragma unroll
                for (int jp = 0; jp < 2; ++jp) { const int c0 = 4 * n + 2 * jp;
                    const f32x2 w0 = *(const PG8_LAS f32x2*)(E + 1280 + chl + c0), w1 = *(const PG8_LAS f32x2*)(E + 1280 + 128 + chl + c0), w2 = *(const PG8_LAS f32x2*)(E + 1280 + 256 + chl + c0), bb = *(const PG8_LAS f32x2*)(E + 1280 + 384 + chl + c0);
                    f32x2 pe = (f32x2){0.f, 0.f}, ne = (f32x2){0.f, 0.f};
                    if (kb >= 1) pe = *(const PG8_LAS f32x2*)(E + 512 + (kb - 1) * 128 + chl + c0);
                    if (kb <= 2) ne = *(const PG8_LAS f32x2*)(E + (kb + 1) * 128 + chl + c0);
                    float oo[4][2];
#pragma unroll
                    for (int jj = 0; jj < 2; ++jj) { const int j = 2 * jp + jj;
                        float g[4], R[4], L[4];
#pragma unroll
                        for (int m = 0; m < 4; ++m) { g[m] = acc[ai][0][m][n][j] * r2[ai][m]; R[m] = __shfl(g[m], lprev); L[m] = __shfl(g[m], lnext); }
#pragma unroll
                        for (int m = 0; m < 4; ++m) { float gp = (fr == 0) ? ((m == 0) ? pe[jj] : R[(m + 3) & 3]) : R[m]; float gn = (fr == 15) ? ((m == 3) ? ne[jj] : L[(m + 1) & 3]) : L[m];
                            if (pz[m]) gp = 0.f; if (nz[m]) gn = 0.f;
                            oo[m][jj] = w0[jj] * gp + w1[jj] * g[m] + w2[jj] * gn + bb[jj]; } }
#pragma unroll
                    for (int m = 0; m < 4; ++m) { const f32x2 ge = gelu_pk((f32x2){oo[m][0], oo[m][1]});
                        pk[m][2 * n + jp] = cvt_pk_bf16(ge.x * acc[ai][1][m][n][2 * jp] * r2[ai][m], ge.y * acc[ai][1][m][n][2 * jp + 1] * r2[ai][m]); } }
#pragma unroll
            for (int m = 0; m < 4; ++m) { const int rl = ai * HALF + wr * 64 + m * 16 + fr, tg = rowbase + rl;
                u32x4 w; w.x = pk[m][0]; w.y = pk[m][1]; w.z = pk[m][2]; w.w = pk[m][3];
                if (rl >= 1 && rl <= 254 && tg < 16384) *(u32x4*)(h + (size_t)tg * 5504 + ch) = w; } }
    }
};
struct Epi4 {
    static constexpr bool PERM = true, AFTER_DRAIN = false;
    const bf16_t* xb2; float* xo; float* ss3;
    __device__ __forceinline__ void operator()(const f32x4 (&acc)[2][2][4][2], const Unit& u, int wr, int wc, int fr, int fq) const {
        const int row0 = u.pm * BM + wr * 64 + fr, col0 = u.pn * BM + wc * 32 + 8 * fq;
#pragma unroll
        for (int ai = 0; ai < 2; ++ai) {
            u32x4 xv[4][2];
#pragma unroll
            for (int m = 0; m < 4; ++m) { const size_t off = (size_t)(row0 + ai * HALF + m * 16) * 2048 + col0;
#pragma unroll
                for (int bj = 0; bj < 2; ++bj) xv[m][bj] = *(const u32x4*)(xb2 + off + bj * HALF); }
#pragma unroll
            for (int m = 0; m < 4; ++m) { const int r = row0 + ai * HALF + m * 16; float s = 0.f; const size_t off = (size_t)r * 2048 + col0;
#pragma unroll
                for (int bj = 0; bj < 2; ++bj) { const u32x4 xw = xv[m][bj];
                    const f32x4 x0 = (f32x4){__builtin_bit_cast(float, xw.x << 16), __builtin_bit_cast(float, xw.x & 0xffff0000u), __builtin_bit_cast(float, xw.y << 16), __builtin_bit_cast(float, xw.y & 0xffff0000u)};
                    const f32x4 x4 = (f32x4){__builtin_bit_cast(float, xw.z << 16), __builtin_bit_cast(float, xw.z & 0xffff0000u), __builtin_bit_cast(float, xw.w << 16), __builtin_bit_cast(float, xw.w & 0xffff0000u)};
                    const f32x4 v0 = x0 + acc[ai][bj][m][0], v1 = x4 + acc[ai][bj][m][1];
                    *(f32x4*)(xo + off + bj * HALF) = v0; *(f32x4*)(xo + off + bj * HALF + 4) = v1;
                    s += (v0[0] * v0[0] + v0[1] * v0[1]) + (v0[2] * v0[2] + v0[3] * v0[3]) + (v1[0] * v1[0] + v1[1] * v1[1]) + (v1[2] * v1[2] + v1[3] * v1[3]); }
                s += __shfl_xor(s, 16); s += __shfl_xor(s, 32);
                if (fq == 0) atomicAdd(ss3 + r, s); }
            asm volatile("" ::: "memory"); }
    }
};
}

template <int MODE  , bool SCALED>
__device__ __forceinline__ void p0_transpose_item(const float* W, int K, int N, bf16* WT, const float* kscale, LAS float* scr, int item, int lane) {
    const int nblk = N / 32, kb = item / nblk, nb = item % nblk, k0 = 64 * kb, n0 = 32 * nb;
    float v[32];
#pragma unroll
    for (int i = 0; i < 32; ++i) v[i] = W[(size_t)(k0 + 2 * i + (lane >> 5)) * N + n0 + (lane & 31)];
    if (SCALED) {
#pragma unroll
        for (int i = 0; i < 32; ++i) v[i] *= kscale[k0 + 2 * i + (lane >> 5)]; }
#pragma unroll
    for (int i = 0; i < 32; ++i) scr[(2 * i + (lane >> 5)) * 33 + (lane & 31)] = v[i];
    LDS_WAIT(); asm volatile("" ::: "memory");
    const int c = lane & 7;
    int r0 = n0;
    if (MODE == 1) { const int half = n0 / DFF, rem = n0 % DFF, tile = rem / 128, j = rem % 128; r0 = tile * 256 + half * 128 + j; }
#pragma unroll
    for (int j = 0; j < 4; ++j) { const int n = (lane >> 3) + 8 * j; const LAS float* s = scr + (8 * c) * 33 + n;
        v4u o; o.x = pk2(s[0 * 33], s[1 * 33]); o.y = pk2(s[2 * 33], s[3 * 33]); o.z = pk2(s[4 * 33], s[5 * 33]); o.w = pk2(s[6 * 33], s[7 * 33]);
        *(GAS v4u*)(WT + (size_t)(r0 + n) * K + k0 + 8 * c) = o; }
    LDS_WAIT(); asm volatile("" ::: "memory");
}

__device__ __forceinline__ void p0_prologue(Frame& F) {
    LAS float* scr = (LAS float*)(F.lds + RING_OFF + F.wave * 16384);
    const int gw = F.vcu * NWAVES + F.wave, NGW = F.G * NWAVES;
    const int lane = F.lane;
    for (int i = gw * 64 + lane; i < 4 * M; i += NGW * 64) F.ssv[i] = 0.f;
    constexpr int I_IN = (DM / 64) * (DIN / 32), I_OUT = (DM / 64) * (DM / 32), I_UP = (DM / 64) * (NUP / 32), I_DN = (DFF / 64) * (DM / 32);
    constexpr int NITEMS = I_IN + I_OUT + I_UP + I_DN;
    for (int it = gw; it < NITEMS; it += NGW) {
        int r = it;
        if (r < I_IN) { p0_transpose_item<0, false>(F.w_in, DM, DIN, F.Wt_in, nullptr, scr, r, lane); continue; } r -= I_IN;
        if (r < I_OUT) { const int kb = r / (DM / 32); p0_transpose_item<0, true>(F.w_out, DM, DM, F.Wt_out, (kb < 16) ? F.on_a_g : (F.on_b_g - 1024), scr, r, lane); continue; } r -= I_OUT;
        if (r < I_UP) { p0_transpose_item<1, true>(F.w_up, DM, NUP, F.Wt_up, F.norm2_g, scr, r, lane); continue; } r -= I_UP;
        p0_transpose_item<0, false>(F.w_down, DFF, DM, F.Wt_dn, nullptr, scr, r, lane);
    }
    for (int m = gw; m < M; m += NGW) {
        const GAS f32x4* xr = (const GAS f32x4*)(F.x + (size_t)m * DM) + lane;
        f32x4 v[8]; float s = 0.f;
#pragma unroll
        for (int j = 0; j < 8; ++j) { v[j] = xr[64 * j]; s += (v[j].x * v[j].x + v[j].y * v[j].y) + (v[j].z * v[j].z + v[j].w * v[j].w); }
        const float r = rsq(wave_sum(s) * (1.0f / DM) + EPS);
        GAS unsigned long long* o8 = (GAS unsigned long long*)(F.xn1 + (size_t)m * DM) + lane;
#pragma unroll
        for (int j = 0; j < 8; ++j) { const f32x4 g = ((const GAS f32x4*)F.norm1_g)[lane + 64 * j]; const f32x4 o = v[j] * r * g;
            o8[64 * j] = (unsigned long long)pk2(o.x, o.y) | ((unsigned long long)pk2(o.z, o.w) << 32); }
    }
    for (int t = gw; t < SEQ; t += NGW) {
        float z = 0.f;
        { const float tl = (float)t / (float)(SEQ - 1); const float w = (6.283185307179586f / (float)SEQ) * (float)t;
          if (lane == 0) z = tl;
          else if (lane <= 16) { const float f = 1e-4f + (float)(lane - 1) * ((15.0f - 1e-4f) / 15.0f); z = cosf(f * w); }
          else if (lane <= 32) { const float f = 1e-4f + (float)(lane - 17) * ((15.0f - 1e-4f) / 15.0f); z = -sinf(f * w); } }
        const float fr = F.f_freq[lane];
        float a = F.f_b1[lane];
        for (int k = 0; k < 33; ++k) a += __shfl(z, k) * F.f_w1[k * 64 + lane];
        float h = sinf(fr * a);
        a = F.f_b2[lane];
        for (int k = 0; k < 64; ++k) a += __shfl(h, k) * F.f_w2[k * 64 + lane];
        h = sinf(fr * a);
        a = F.f_b3[lane];
        for (int k = 0; k < 64; ++k) a += __shfl(h, k) * F.f_w3[k * 64 + lane];
        h = sinf(fr * a);
        F.h3[(size_t)t * 64 + lane] = h;
    }
}

struct SguRaw { f32x4 wa[8]; v4u zb[4]; u32x2 zu[2][4]; float sv; };
__device__ __forceinline__ void sgu_load(Frame& F, int unit, SguRaw& R) {
    const int h = unit & 7, pos0 = (unit >> 3) * 128, t = F.tid, lane = F.lane, w = F.wave;
    { const int i = t >> 2, j0 = (t & 3) * 32; const GAS f32x4* wrow = (const GAS f32x4*)(F.sgu_w + ((size_t)h * 128 + i) * 128 + j0);
#pragma unroll
      for (int q = 0; q < 8; ++q) R.wa[q] = wrow[q]; }
    { const int d = t >> 2, c0 = (t & 3) * 32; const GAS v4u* src = (const GAS v4u*)(F.zvT + (size_t)(h * 128 + d) * M + pos0 + c0);
#pragma unroll
      for (int q = 0; q < 4; ++q) R.zb[q] = src[q]; }
    R.sv = F.ssv[pos0 + (t & 127)];
    const int iw = w & 3, dw = w >> 2, r = lane & 15, q = lane >> 4;
#pragma unroll
    for (int it = 0; it < 2; ++it)
#pragma unroll
        for (int dt = 0; dt < 4; ++dt) R.zu[it][dt] = *(const GAS u32x2*)(F.zu + (size_t)(pos0 + 32 * iw + 16 * it + r) * DA + h * 128 + 64 * dw + 16 * dt + 4 * q);
}
__device__ __forceinline__ void sgu_phase(Frame& F, float* ssa_dst) {
    LAS unsigned char* As = F.lds; LAS unsigned char* Bs = F.lds + 128 * 272; LAS float* rvs = (LAS float*)(F.lds + 2 * 128 * 272);
    const int t = F.tid, lane = F.lane, w = F.wave, NU = BATCH * (SEQ / 128) * NHA;
    int unit = F.vcu;
    SguRaw R;
    if (unit < NU) sgu_load(F, unit, R);
#pragma unroll 1
    for (; unit < NU; unit += F.G) {
        const int h = unit & 7, pos0 = (unit >> 3) * 128;
        if (t < 128) rvs[t] = rsq(R.sv * (1.f / 1024.f) + EPS);
        __syncthreads();
        {
            const int i = t >> 2, j0 = (t & 3) * 32;
#pragma unroll
            for (int q = 0; q < 4; ++q) { const f32x4 r0 = *(const LAS f32x4*)(rvs + j0 + 8 * q), r1 = *(const LAS f32x4*)(rvs + j0 + 8 * q + 4); const f32x4 w0 = R.wa[2 * q] * r0, w1 = R.wa[2 * q + 1] * r1;
                v4u o; o.x = pk2(w0.x, w0.y); o.y = pk2(w0.z, w0.w); o.z = pk2(w1.x, w1.y); o.w = pk2(w1.z, w1.w);
                *(LAS v4u*)(As + i * 272 + (j0 + 8 * q) * 2) = o; }
#pragma unroll
            for (int q = 0; q < 4; ++q) *(LAS v4u*)(Bs + i * 272 + (j0 + 8 * q) * 2) = R.zb[q];
        }
        u32x2 zu[2][4];
#pragma unroll
        for (int it = 0; it < 2; ++it)
#pragma unroll
            for (int dt = 0; dt < 4; ++dt) zu[it][dt] = R.zu[it][dt];
        asm volatile("" ::: "memory");
        if (unit + F.G < NU) sgu_load(F, unit + F.G, R);
        __syncthreads();
        const int iw = w & 3, dw = w >> 2, r = lane & 15, q = lane >> 4;
        f32x4 acc[2][4];
#pragma unroll
        for (int it = 0; it < 2; ++it)
#pragma unroll
            for (int dt = 0; dt < 4; ++dt) acc[it][dt] = (f32x4){0.f, 0.f, 0.f, 0.f};
#pragma unroll
        for (int ks = 0; ks < 4; ++ks) {
            bf16x8 a[2], b[4];
#pragma unroll
            for (int it = 0; it < 2; ++it) a[it] = *(const LAS bf16x8*)(As + (32 * iw + 16 * it + r) * 272 + (32 * ks + 8 * q) * 2);
#pragma unroll
            for (int dt = 0; dt < 4; ++dt) b[dt] = *(const LAS bf16x8*)(Bs + (64 * dw + 16 * dt + r) * 272 + (32 * ks + 8 * q) * 2);
#pragma unroll
            for (int it = 0; it < 2; ++it)
#pragma unroll
                for (int dt = 0; dt < 4; ++dt) acc[it][dt] = __builtin_amdgcn_mfma_f32_16x16x32_bf16(b[dt], a[it], acc[it][dt], 0, 0, 0);
        }
#pragma unroll
        for (int it = 0; it < 2; ++it) { const int i = 32 * iw + 16 * it + r, row = pos0 + i; const float bias = F.sgu_b[h * 128 + i]; float ss = 0.f;
#pragma unroll
            for (int dt = 0; dt < 4; ++dt) { const int col = h * 128 + 64 * dw + 16 * dt + 4 * q;
                const u32x2 zz = zu[it][dt];
                const float y0 = bflo(zz.x) * (acc[it][dt][0] + bias), y1 = bfhi(zz.x) * (acc[it][dt][1] + bias), y2 = bflo(zz.y) * (acc[it][dt][2] + bias), y3 = bfhi(zz.y) * (acc[it][dt][3] + bias);
                ss += (y0 * y0 + y1 * y1) + (y2 * y2 + y3 * y3);
                u32x2 o; o.x = pk2(y0, y1); o.y = pk2(y2, y3);
                *(GAS u32x2*)(F.mrg + (size_t)row * DM + col) = o; }
            ss += __shfl_xor(ss, 16); ss += __shfl_xor(ss, 32);
            if (q == 0) atomicAdd(ssa_dst + row, ss); }
        __syncthreads();
    }
}

typedef float f32x16 __attribute__((ext_vector_type(16)));
__device__ __forceinline__ void p1_filter_gemm(Frame& F) {
    const int gw = F.vcu * NWAVES + F.wave, NGW = F.G * NWAVES, lane = F.lane, i = lane & 31, hh = lane >> 5;
    for (int tile = gw; tile < 64 * 256; tile += NGW) { const int ct = tile >> 8, tt = tile & 255;
        f32x16 acc;
#pragma unroll
        for (int r = 0; r < 16; ++r) acc[r] = 0.f;
        const GAS f32x4* hrow = (const GAS f32x4*)(F.h3 + (size_t)(tt * 32 + i) * 64 + 32 * hh);
        const GAS float* wcol = (const GAS float*)F.f_wout + (size_t)(32 * hh) * 2048 + ct * 32 + i;
#pragma unroll
        for (int k4 = 0; k4 < 8; ++k4) { const f32x4 hv = hrow[k4];
            acc = __builtin_amdgcn_mfma_f32_32x32x2f32(wcol[(size_t)(4 * k4 + 0) * 2048], hv.x, acc, 0, 0, 0);
            acc = __builtin_amdgcn_mfma_f32_32x32x2f32(wcol[(size_t)(4 * k4 + 1) * 2048], hv.y, acc, 0, 0, 0);
            acc = __builtin_amdgcn_mfma_f32_32x32x2f32(wcol[(size_t)(4 * k4 + 2) * 2048], hv.z, acc, 0, 0, 0);
            acc = __builtin_amdgcn_mfma_f32_32x32x2f32(wcol[(size_t)(4 * k4 + 3) * 2048], hv.w, acc, 0, 0, 0); }
#pragma unroll
        for (int r = 0; r < 16; ++r) { const int row = (r & 3) + 8 * (r >> 2) + 4 * hh; F.hT[(size_t)(ct * 32 + row) * SEQ + tt * 32 + i] = acc[r]; }
    }
}

struct Raw8 { v4u v; unsigned hm, hp; };
__device__ __forceinline__ Raw8 raw8_load(const bf16* p, int pos0) {
    Raw8 r; r.v = *(const GAS v4u*)(p + pos0); r.hm = p[pos0 > 0 ? pos0 - 1 : 0]; r.hp = p[pos0 + 8 < M ? pos0 + 8 : M - 1]; return r;
}
__device__ __forceinline__ void dwc3x8(const Raw8& r, int t0, float w0, float w1, float w2, float b, float (&o)[8]) {
    float x[10];
    x[0] = (t0 > 0) ? bf2f((unsigned short)r.hm) : 0.f; x[9] = (t0 + 8 < SEQ) ? bf2f((unsigned short)r.hp) : 0.f;
    x[1] = bflo(r.v.x); x[2] = bfhi(r.v.x); x[3] = bflo(r.v.y); x[4] = bfhi(r.v.y); x[5] = bflo(r.v.z); x[6] = bfhi(r.v.z); x[7] = bflo(r.v.w); x[8] = bfhi(r.v.w);
#pragma unroll
    for (int k = 0; k < 8; ++k) o[k] = x[k] * w0 + x[k + 1] * w1 + x[k + 2] * w2 + b;
}
__device__ __forceinline__ void fft_fwd_all(LAS cpx* X, int tid) {
    int nb = 2; asm volatile("" : "+s"(nb));
#pragma unroll 1
    for (int i = 0; i < nb; ++i) fft_pass16<false, 1024>(X, tid + 512 * i);
    __syncthreads();
#pragma unroll 1
    for (int i = 0; i < nb; ++i) fft_pass16<false, 64>(X, tid + 512 * i);
    __syncthreads();
#pragma unroll 1
    for (int i = 0; i < nb; ++i) fft_pass16<false, 4>(X, tid + 512 * i);
    __syncthreads();
#pragma unroll 2
    for (int i = 0; i < 8; ++i) fft_pass4<false>(X, tid + 512 * i);
    __syncthreads();
}
__device__ __forceinline__ void fft_inv_all(LAS cpx* X, int tid) {
    int nb = 2; asm volatile("" : "+s"(nb));
#pragma unroll 2
    for (int i = 0; i < 8; ++i) fft_pass4<true>(X, tid + 512 * i);
    __syncthreads();
#pragma unroll 1
    for (int i = 0; i < nb; ++i) fft_pass16<true, 4>(X, tid + 512 * i);
    __syncthreads();
#pragma unroll 1
    for (int i = 0; i < nb; ++i) fft_pass16<true, 64>(X, tid + 512 * i);
    __syncthreads();
#pragma unroll 1
    for (int i = 0; i < nb; ++i) fft_pass16<true, 1024>(X, tid + 512 * i);
    __syncthreads();
}
__device__ __forceinline__ void hyena_phase(Frame& F) {
    LAS cpx* X = (LAS cpx*)F.lds; LAS float* red = (LAS float*)(F.lds + RED_OFF);
    const int tid = F.tid;
    const float min_decay = logf(1e-2f) / 1.5f, max_decay = logf(1e-2f) / 0.3f;
    int c = F.vcu;
#pragma unroll 1
    for (; c < DB; c += F.G) {
        const float delta = fabsf(min_decay + (float)c * ((max_decay - min_decay) / 1023.0f));
        const bf16* p0 = F.binT + (size_t)c * M; const bf16* p1 = F.binT + (size_t)(1024 + c) * M; const bf16* p2 = F.binT + (size_t)(2048 + c) * M;
        {
            float l1 = 0.f;
            const float* hf = F.hT + (size_t)c * SEQ; const float* hb = F.hT + (size_t)(1024 + c) * SEQ;
#pragma unroll 1
            for (int i0 = 0; i0 < 16; i0 += 8) { float vf[8], vb[8];
#pragma unroll
                for (int i = 0; i < 8; ++i) { vf[i] = hf[tid + 512 * (i0 + i)]; vb[i] = hb[tid + 512 * (i0 + i)]; }
#pragma unroll
                for (int i = 0; i < 8; ++i) { const int d = tid + 512 * (i0 + i); const float win = __expf(-((float)d * (1.0f / (float)(SEQ - 1))) * delta);
                    const float kf = vf[i] * win, kb = vb[i] * win;
                    X[fft_p(d)] = cpx{kf, 0.f}; l1 += fabsf(kf);
                    if (d >= 1) { X[fft_p(FFT_N - d)] = cpx{kb, 0.f}; l1 += fabsf(kb); } else X[fft_p(SEQ)] = cpx{0.f, 0.f}; } }
            l1 = wave_sum(l1);
            if (F.lane == 0) red[F.wave] = l1;
        }
        asm volatile("" ::: "memory");
        Raw8 r1a[2], r2a[2], r1b[2], r2b[2];
#pragma unroll
        for (int i = 0; i < 2; ++i) { const int t0 = 8 * (tid + 512 * i); r1a[i] = raw8_load(p1, t0); r2a[i] = raw8_load(p2, t0); r1b[i] = raw8_load(p1, SEQ + t0); r2b[i] = raw8_load(p2, SEQ + t0); }
        __syncthreads();
        float tot = 0.f;
#pragma unroll
        for (int i = 0; i < NWAVES; ++i) tot += red[i];
        const float scale = 1.0f / (tot + EPS);
        const float dsk = F.d_skip[c];
        fft_fwd_all(X, tid);
        typedef _Float16 h16x4 __attribute__((ext_vector_type(4)));
        h16x4 kreg[17];
        {
            const LAS f32x4* src = (const LAS f32x4*)X;
#pragma unroll
            for (int i = 0; i < 17; ++i) kreg[i] = __builtin_convertvector(src[tid + 512 * i] * scale, h16x4);
        }
        __syncthreads();
        {
            const float w10 = F.hy_conv_w[1024 + c], w11 = F.hy_conv_w[3072 + 1024 + c], w12 = F.hy_conv_w[6144 + 1024 + c], b1 = F.hy_conv_b[1024 + c];
            const float w20 = F.hy_conv_w[2048 + c], w21 = F.hy_conv_w[3072 + 2048 + c], w22 = F.hy_conv_w[6144 + 2048 + c], b2 = F.hy_conv_b[2048 + c];
#pragma unroll
            for (int i = 0; i < 2; ++i) { const int t0 = 8 * (tid + 512 * i);
                float a1[8], a2[8], c1[8], c2[8];
                dwc3x8(r1a[i], t0, w10, w11, w12, b1, a1); dwc3x8(r2a[i], t0, w20, w21, w22, b2, a2);
                dwc3x8(r1b[i], t0, w10, w11, w12, b1, c1); dwc3x8(r2b[i], t0, w20, w21, w22, b2, c2);
                LAS f32x4* dst = (LAS f32x4*)(X + fft_p(t0)); LAS f32x4* dz = (LAS f32x4*)(X + fft_p(SEQ + t0));
#pragma unroll
                for (int k = 0; k < 4; ++k) { dst[k] = (f32x4){a1[2 * k] * a2[2 * k], c1[2 * k] * c2[2 * k], a1[2 * k + 1] * a2[2 * k + 1], c1[2 * k + 1] * c2[2 * k + 1]}; dz[k] = (f32x4){0.f, 0.f, 0.f, 0.f}; } }
        }
        asm volatile("" ::: "memory");
        Raw8 r0a[2], r0b[2];
#pragma unroll
        for (int i = 0; i < 2; ++i) { const int t0 = 8 * (tid + 512 * i); r0a[i] = raw8_load(p0, t0); r0b[i] = raw8_load(p0, SEQ + t0); }
        __syncthreads();
#ifdef PROBE_FFT
        fft_fwd_all(X, tid); fft_inv_all(X, tid);
        { LAS f32x4* xx = (LAS f32x4*)X;
#pragma unroll 4
          for (int i = 0; i < 17; ++i) xx[tid + 512 * i] = xx[tid + 512 * i] * (1.0f / (float)FFT_N); }
        __syncthreads();
#endif
        fft_fwd_all(X, tid);
        {
            LAS f32x4* xx = (LAS f32x4*)X;
            const float invn = 1.0f / (float)FFT_N;
#pragma unroll
            for (int i = 0; i < 17; ++i) { const f32x4 a = xx[tid + 512 * i]; f32x4 k = __builtin_convertvector(kreg[i], f32x4); k.x += dsk; k.z += dsk;
                xx[tid + 512 * i] = (f32x4){(a.x * k.x - a.y * k.y) * invn, (a.x * k.y + a.y * k.x) * invn, (a.z * k.z - a.w * k.w) * invn, (a.z * k.w + a.w * k.z) * invn}; }
        }
        __syncthreads();
        fft_inv_all(X, tid);
        {
            const float w00 = F.hy_conv_w[c], w01 = F.hy_conv_w[3072 + c], w02 = F.hy_conv_w[6144 + c], b0 = F.hy_conv_b[c];
#pragma unroll
            for (int i = 0; i < 2; ++i) { const int t0 = 8 * (tid + 512 * i);
                float xa[8], xb[8];
                dwc3x8(r0a[i], t0, w00, w01, w02, b0, xa); dwc3x8(r0b[i], t0, w00, w01, w02, b0, xb);
                const LAS f32x4* src = (const LAS f32x4*)(X + fft_p(t0));
                const f32x4 y0 = src[0], y1 = src[1], y2 = src[2], y3 = src[3];
                v4u oa, ob;
                oa.x = pk2(xa[0] * y0.x, xa[1] * y0.z); oa.y = pk2(xa[2] * y1.x, xa[3] * y1.z); oa.z = pk2(xa[4] * y2.x, xa[5] * y2.z); oa.w = pk2(xa[6] * y3.x, xa[7] * y3.z);
                ob.x = pk2(xb[0] * y0.y, xb[1] * y0.w); ob.y = pk2(xb[2] * y1.y, xb[3] * y1.w); ob.z = pk2(xb[4] * y2.y, xb[5] * y2.w); ob.w = pk2(xb[6] * y3.y, xb[7] * y3.w);
                *(GAS v4u*)(F.ybT + (size_t)c * M + t0) = oa; *(GAS v4u*)(F.ybT + (size_t)c * M + SEQ + t0) = ob; }
        }
        __syncthreads();
    }
}

__device__ __forceinline__ void p3_merge(Frame& F) {
    for (int i = F.vcu * 512 + F.tid; i < 129 * (DM / 8); i += F.G * 512) { const int r = i / (DM / 8), q = i % (DM / 8); const int row = (r == 128) ? -1 : M + r;
        *(GAS v4u*)(F.xb2 + (ptrdiff_t)row * DM + q * 8) = (v4u){0u, 0u, 0u, 0u}; }
    LAS unsigned char* T = F.lds;
    const int tid = F.tid, lane = F.lane, w = F.wave;
    for (int tile = F.vcu; tile < M / 64; tile += F.G) {
        const int pos0 = tile * 64;
#pragma unroll 4
        for (int k = 0; k < 16; ++k) { const int row = (tid >> 3) + 64 * k; const v4u v = *(const GAS v4u*)(F.ybT + (size_t)row * M + pos0 + (tid & 7) * 8);
            LAS unsigned* dst = (LAS unsigned*)(T + row * 132 + (tid & 7) * 16); dst[0] = v.x; dst[1] = v.y; dst[2] = v.z; dst[3] = v.w; }
        __syncthreads();
        float ssav[8];
#pragma unroll
        for (int i = 0; i < 8; ++i) ssav[i] = F.ssa[pos0 + w * 8 + i];
#pragma unroll
        for (int i = 0; i < 8; ++i) { const int p = w * 8 + i; float a[8], b[8]; float s = 0.f;
#pragma unroll
            for (int k = 0; k < 8; ++k) { const int c = 2 * lane + 128 * k;
                a[k] = bf2f(*(const LAS unsigned short*)(T + c * 132 + p * 2)); b[k] = bf2f(*(const LAS unsigned short*)(T + (c + 1) * 132 + p * 2)); s += a[k] * a[k] + b[k] * b[k]; }
            s = wave_sum(s);
            const float rb = rsq(s * (1.f / 1024.f) + EPS), ra = rsq(ssav[i] * (1.f / 1024.f) + EPS), sc = rb / ra;
#pragma unroll
            for (int k = 0; k < 8; ++k) *(GAS unsigned*)(F.mrg + (size_t)(pos0 + p) * DM + 1024 + 2 * lane + 128 * k) = pk2(a[k] * sc, b[k] * sc); }
        __syncthreads();
    }
}

__device__ __forceinline__ void p_final(Frame& F, float* dst) {
    const int gw = F.vcu * NWAVES + F.wave, NGW = F.G * NWAVES, lane = F.lane;
    for (int m = gw; m < M; m += NGW) {
        const float r = rsq(F.ss3[m] * (1.0f / DM) + EPS);
        const GAS f32x4* xr = (const GAS f32x4*)(F.out + (size_t)m * DM) + lane; GAS f32x4* xw = (GAS f32x4*)(dst + (size_t)m * DM) + lane;
#pragma unroll
        for (int j = 0; j < 8; ++j) { const f32x4 g = ((const GAS f32x4*)F.final_g)[lane + 64 * j]; xw[64 * j] = xr[64 * j] * r * g; }
    }
}

constexpr int NPHASE = 8;
template <int PHMASK, int LO, int HI> __global__ void __launch_bounds__(NWAVES * 64, 2) fwd_kernel(Args args) {
    extern __shared__ __attribute__((aligned(16))) unsigned char lds_dyn[];
    {
        LAS unsigned char* l = (LAS unsigned char*)lds_dyn;
        for (int u = threadIdx.x; u < (LDS_BYTES - LDSCTL_OFF) / 4; u += NWAVES * 64) ((LAS unsigned*)(l + LDSCTL_OFF))[u] = 0u;
        __syncthreads();
        if (HI - LO > 1) (void)xcd_barrier_post((unsigned*)((gu32*)(args.ws + WS_CTL) + CW_BAR), (volatile LAS unsigned*)(l + MISC_OFF) + 8);
    }
    constexpr int lo = LO, hi = HI;
#define IN(k) (((PHMASK >> (k)) & 1) && lo <= (k) && (k) < hi)
#define SEAM(k) do { if (IN(k) && IN((k) + 1)) { CArgsP A_ = kargs(); XcdBarrier bar; bar.bar = (unsigned*)((gu32*)(A_->ws + WS_CTL) + CW_BAR); bar.x = xb_xcc_id(); \
        bar.st = (volatile LAS unsigned*)((LAS unsigned char*)lds_dyn + MISC_OFF) + 8; xcd_barrier(bar); } } while (0)

#ifndef PROBE_PHASE
#define PROBE_PHASE -1
#endif
#define NREP(k) (((k) == PROBE_PHASE) ? 2 : 1)
#define LASTREP(k) (rep == NREP(k) - 1)
#define REPSEAM(k) do { if (!LASTREP(k)) { CArgsP A_ = kargs(); XcdBarrier bar; bar.bar = (unsigned*)((gu32*)(A_->ws + WS_CTL) + CW_BAR); bar.x = xb_xcc_id(); \
        bar.st = (volatile LAS unsigned*)((LAS unsigned char*)lds_dyn + MISC_OFF) + 8; xcd_barrier(bar); } } while (0)
    if (IN(0)) for (int rep = 0; rep < NREP(0); ++rep) { Frame F; frame_ptrs(F); p0_prologue(F); REPSEAM(0); }
    SEAM(0);
    if (IN(1)) for (int rep = 0; rep < NREP(1); ++rep) {
        Frame F; frame_ptrs(F);
        {
            pg8::Gemm g{F.xn1, F.Wt_in, M, DA, DM}; pg8::StaticOrder S; S.init(M, DA, F.G, (int)blockIdx.x);
            pg8::EpiBf16<1> E{F.zu, DA, nullptr, 0, 0, 1.f};
            pg8::gemm_phase<pg8::EpiBf16<1>, pg8::StaticOrder, PG8_ALIGN, PG8_SP2>(F.lds + RING_OFF, g, S, E); }
        {
            pg8::Gemm g{F.Wt_in + (size_t)DA * DM, F.xn1, DIN - DA, M, DM}; pg8::StaticOrder S; S.init(DIN - DA, M, F.G, (int)blockIdx.x);
            pg8::Epi1b E{F.zvT, F.binT, F.sgu_norm_g, LASTREP(1) ? F.ssv : F.dum_ss};
            pg8::gemm_phase<pg8::Epi1b, pg8::StaticOrder, PG8_ALIGN, PG8_SP2>(F.lds + RING_OFF, g, S, E); }
        p1_filter_gemm(F);
        REPSEAM(1);
    }
    SEAM(1);
    if (IN(2)) for (int rep = 0; rep < NREP(2); ++rep) {
        Frame F; frame_ptrs(F);
        if (!LASTREP(2)) F.ssa = F.dum_ss;
#ifndef PROBE_SUB
#define PROBE_SUB -1
#endif
#ifdef PROBE_SGU
        sgu_phase(F, F.dum_ss);
#endif
        if (LASTREP(2) || PROBE_SUB != 1) sgu_phase(F, F.ssa);
        if (LASTREP(2) || PROBE_SUB != 0) hyena_phase(F);
        REPSEAM(2);
    }
    SEAM(2);
    if (IN(3)) for (int rep = 0; rep < NREP(3); ++rep) { Frame F; frame_ptrs(F); p3_merge(F); REPSEAM(3); }
    SEAM(3);
    if (IN(4)) for (int rep = 0; rep < NREP(4); ++rep) { Frame F; frame_ptrs(F);
        pg8::Gemm g{F.mrg, F.Wt_out, M, DM, DM}; pg8::StaticOrder S; S.init(M, DM, F.G, (int)blockIdx.x);
        pg8::Epi2 E{F.x, F.xb2, F.ssa, LASTREP(4) ? F.ss2 : F.dum_ss};
        pg8::gemm_phase<pg8::Epi2, pg8::StaticOrder, PG8_ALIGN, PG8_SP2>(F.lds + RING_OFF, g, S, E);
        REPSEAM(4);
    }
    SEAM(4);
    if (IN(5)) for (int rep = 0; rep < NREP(5); ++rep) { Frame F; frame_ptrs(F);
        pg8::Gemm g{F.xb2 - DM, F.Wt_up, M, NUP, DM, 254}; pg8::StaticOrder S; S.init_tiles(65, NUP / 256, F.G, (int)blockIdx.x);
        pg8::Epi3 E{F.hb, F.ss2, F.dw_w, F.dw_b, (PG8_LAS float*)(F.lds + RING_BYTES)};
        pg8::gemm_phase<pg8::Epi3, pg8::StaticOrder, true, PG8_SP2>(F.lds + RING_OFF, g, S, E);
        REPSEAM(5);
    }
    SEAM(5);
    if (IN(6)) for (int rep = 0; rep < NREP(6); ++rep) { Frame F; frame_ptrs(F);
        pg8::Gemm g{F.hb, F.Wt_dn, M, DM, DFF}; pg8::StaticOrder S; S.init(M, DM, F.G, (int)blockIdx.x);
        pg8::Epi4 E{F.xb2, LASTREP(6) ? F.out : F.dum_out, LASTREP(6) ? F.ss3 : F.dum_ss};
        pg8::gemm_phase<pg8::Epi4, pg8::StaticOrder, PG8_ALIGN, PG8_SP2>(F.lds + RING_OFF, g, S, E);
        REPSEAM(6);
    }
    SEAM(6);
    if (IN(7)) for (int rep = 0; rep < NREP(7); ++rep) { Frame F; frame_ptrs(F); p_final(F, LASTREP(7) ? F.out : F.dum_out); REPSEAM(7); }
#undef IN
#undef SEAM
}

#ifndef MK_LAUNCHES
#define MK_LAUNCHES 1
#endif
template <int MASK, int LO, int HI> static bool launch_phases(int grid, Args a, hipStream_t stream) {
    static bool attr_done = false;
    if (!attr_done) { if (hipFuncSetAttribute((const void*)fwd_kernel<MASK, LO, HI>, hipFuncAttributeMaxDynamicSharedMemorySize, LDS_BYTES) != hipSuccess) { fprintf(stderr, "kernel_launch: hipFuncSetAttribute failed\n"); return false; } attr_done = true; }
    a.ph_lo = LO; a.ph_hi = HI; a.li = 0;
    hipLaunchKernelGGL((fwd_kernel<MASK, LO, HI>), dim3(grid), dim3(NWAVES * 64), LDS_BYTES, stream, a);
    return true;
}
extern "C" void kernel_launch(void* const* d_in, const int* in_sizes, int n_in, void* d_out, int out_size, void* d_ws, size_t ws_size, hipStream_t stream) {
    static int grid = 0;
    if (grid == 0) {
        if (n_in != 26 || out_size != M * DM || ws_size < WS_END) { fprintf(stderr, "kernel_launch: unexpected shapes: n_in %d out %d ws %zu\n", n_in, out_size, ws_size); grid = -1; return; }
        int dev = 0, cus = 0;
        if (hipGetDevice(&dev) != hipSuccess || hipDeviceGetAttribute(&cus, hipDeviceAttributeMultiprocessorCount, dev) != hipSuccess) { grid = -1; return; }
        (void)hipGetLastError();
        grid = cus;
    }
    if (grid < 0) return;
    (void)hipMemsetAsync((char*)d_ws + WS_CTL, 0, CTL_ZERO_BYTES, stream);
    Args a{};
    for (int i = 0; i < 26; ++i) a.in[i] = (const float*)d_in[i];
    a.out = (float*)d_out; a.ws = (unsigned char*)d_ws;
#if MK_LAUNCHES == 1
    launch_phases<0xFF, 0, NPHASE>(grid, a, stream);
#else
    launch_phases<0x01, 0, 1>(grid, a, stream);
    launch_phases<0x02, 1, 2>(grid, a, stream);
    launch_phases<0x04, 2, 3>(grid, a, stream);
    launch_phases<0x08, 3, 4>(grid, a, stream);
    launch_phases<0x10, 4, 5>(grid, a, stream);
    launch_phases<0x20, 5, 6>(grid, a, stream);
    launch_phases<0x40, 6, 7>(grid, a, stream);
    launch_phases<0x80, 7, 8>(grid, a, stream);
#endif
}
```
